# Optimizing an MI355X kernel written in HIP

```python
import math
import jax, jax.numpy as jnp
from jax import lax
import numpy as np

D_MODEL = 1024
BATCH = 8
SEQ = 4096
DEPTH = 2

MEM_LEN = 256
EPS = 1e-6
D_FF = 2816
CONV_WIDTH = 3
CONV_CH = D_MODEL // 2
SWA_HEADS = 8
SWA_KV_HEADS = 2
SWA_HEAD_DIM = 64
WINDOW = 128
MOBA_HEADS = 8
MOBA_KV_HEADS = 4
MOBA_HEAD_DIM = D_MODEL // MOBA_HEADS
MOBA_BLOCK = 256
MOBA_TOPK = 3
MOBA_Q_CHUNK = 16
REL_BUCKETS = 32
REL_MAX_DIST = 128
REL_HEADS = SWA_HEADS
XA_HEADS = 4
XA_HEAD_DIM = 128
XA_W = XA_HEADS * XA_HEAD_DIM

N_EVEN = (DEPTH + 1) // 2
N_ODD = DEPTH // 2
SWA_Q_W = SWA_HEADS * SWA_HEAD_DIM
SWA_KV_W = SWA_KV_HEADS * SWA_HEAD_DIM
EVEN_IN = 3 * CONV_CH + SWA_Q_W + 2 * SWA_KV_W
EVEN_MIX = CONV_CH + SWA_Q_W
MOBA_Q_W = MOBA_HEADS * MOBA_HEAD_DIM
MOBA_KV_W = MOBA_KV_HEADS * MOBA_HEAD_DIM
ODD_IN = MOBA_Q_W + 2 * MOBA_KV_W

kernel_name = 'hybrid_shortconv_swa_moba_macaron'


def rmsnorm(x, g):
    x32 = x.astype(jnp.float32)
    y = x32 * lax.rsqrt(jnp.mean(x32 * x32, axis=-1, keepdims=True) + EPS)
    return y.astype(x.dtype) * g


def swiglu(x, w_gate, w_up, w_down):
    return (jax.nn.silu(x @ w_gate) * (x @ w_up)) @ w_down


def rel_bucket(dist):
    n = jnp.maximum(dist, 0)
    max_exact = REL_BUCKETS // 2
    nf = jnp.maximum(n, 1).astype(jnp.float32)
    large = max_exact + (jnp.log(nf / max_exact) / math.log(REL_MAX_DIST / max_exact)
                         * (REL_BUCKETS - max_exact)).astype(jnp.int32)
    large = jnp.minimum(large, REL_BUCKETS - 1)
    return jnp.where(n < max_exact, n, large)


def short_conv_mixer(b_gate, c_gate, u, conv_w):
    v = c_gate * u
    S = v.shape[1]
    vp = jnp.pad(v, ((0, 0), (CONV_WIDTH - 1, 0), (0, 0)))
    conv = vp[:, 0:S] * conv_w[0]
    for j in range(1, CONV_WIDTH):
        conv = conv + vp[:, j:j + S] * conv_w[j]
    return b_gate * conv


def sliding_window_attention(q, k, v, sinks, table):
    B, S, H, dh = q.shape
    Hkv = k.shape[2]
    G = H // Hkv
    nb = S // WINDOW
    qb = q.reshape(B, nb, WINDOW, Hkv, G, dh)

    def with_prev(t):
        t = t.reshape(B, nb, WINDOW, Hkv, dh)
        prev = jnp.pad(t, ((0, 0), (1, 0), (0, 0), (0, 0), (0, 0)))[:, :-1]
        return jnp.concatenate([prev, t], axis=2)

    kc, vc = with_prev(k), with_prev(v)
    logits = jnp.einsum('bnqkgd,bnjkd->bnkgqj', qb, kc).astype(jnp.float32) * dh ** -0.5
    qi = jnp.arange(WINDOW)[:, None]
    kj = jnp.arange(2 * WINDOW)[None, :]
    dist = qi + WINDOW - kj
    band = (dist >= 0) & (dist < WINDOW)
    mask = band[None] & ((jnp.arange(nb)[:, None, None] > 0) | (kj >= WINDOW)[None])
    bias = jnp.moveaxis(table[rel_bucket(dist)], -1, 0).reshape(Hkv, G, WINDOW, 2 * WINDOW)
    logits = jnp.where(mask[None, :, None, None], logits + bias, -jnp.inf)
    sink = sinks.astype(jnp.float32).reshape(Hkv, G)[None, None, :, :, None, None]
    m = jnp.maximum(jnp.max(logits, axis=-1, keepdims=True), sink)
    p = jnp.exp(logits - m)
    p = p / (jnp.sum(p, axis=-1, keepdims=True) + jnp.exp(sink - m))
    out = jnp.einsum('bnkgqj,bnjkd->bnqkgd', p.astype(v.dtype), vc)
    return out.reshape(B, S, H * dh)


def moba_attention(q, k, v, table):
    B, S, H, dh = q.shape
    Hkv = k.shape[2]
    G = H // Hkv
    s_pad = -(-S // MOBA_BLOCK) * MOBA_BLOCK
    nblk = s_pad // MOBA_BLOCK
    pad = ((0, 0), (0, s_pad - S), (0, 0), (0, 0))
    kblk = jnp.pad(k, pad).reshape(B, nblk, MOBA_BLOCK, Hkv, dh).transpose(0, 3, 1, 2, 4)
    vblk = jnp.pad(v, pad).reshape(B, nblk, MOBA_BLOCK, Hkv, dh).transpose(0, 3, 1, 2, 4)
    kmean = jnp.mean(kblk.astype(jnp.float32), axis=3)
    nq = S // MOBA_Q_CHUNK
    qc = q.reshape(B, nq, MOBA_Q_CHUNK, Hkv, G, dh).transpose(1, 0, 3, 4, 2, 5)
    topk = min(MOBA_TOPK, nblk)
    n_sel = topk * MOBA_BLOCK
    scale = dh ** -0.5
    b_ix = jnp.arange(B)[:, None, None, None, None]
    k_ix = jnp.arange(Hkv)[None, :, None, None, None]
    tbl = table.T.reshape(Hkv, G, REL_BUCKETS)
    k6 = jnp.arange(Hkv)[None, :, None, None, None, None]
    g6 = jnp.arange(G)[None, None, :, None, None, None]
    blk_ids = jnp.arange(nblk)
    offs = jnp.arange(MOBA_BLOCK)

    def one_chunk(args):
        ci, qx = args
        t = ci * MOBA_Q_CHUNK + jnp.arange(MOBA_Q_CHUNK)
        own = (ci * MOBA_Q_CHUNK) // MOBA_BLOCK
        gate = jnp.einsum('bkgqd,bknd->bkgqn', qx.astype(jnp.float32), kmean)
        gate = jnp.where(blk_ids < own, gate, -jnp.inf)
        _, sel = lax.top_k(gate, topk)
        valid = sel < own
        ks = kblk[b_ix, k_ix, sel]
        vs = vblk[b_ix, k_ix, sel]
        dist_sel = t[:, None, None] - (sel[..., None] * MOBA_BLOCK + offs)
        l_sel = jnp.einsum('bkgqd,bkgqsnd->bkgqsn', qx, ks).astype(jnp.float32) * scale
        l_sel = jnp.where(valid[..., None], l_sel + tbl[k6, g6, rel_bucket(dist_sel)], -jnp.inf)
        k_own = lax.dynamic_index_in_dim(kblk, own, axis=2, keepdims=False)
        v_own = lax.dynamic_index_in_dim(vblk, own, axis=2, keepdims=False)
        dist_own = t[:, None] - (own * MOBA_BLOCK + offs)[None, :]
        l_own = jnp.einsum('bkgqd,bknd->bkgqn', qx, k_own).astype(jnp.float32) * scale
        l_own = jnp.where(dist_own >= 0, l_own + tbl[:, :, rel_bucket(dist_own)], -jnp.inf)
        logits = jnp.concatenate([l_sel.reshape(l_sel.shape[:4] + (n_sel,)), l_own], axis=-1)
        p = jax.nn.softmax(logits, axis=-1).astype(v.dtype)
        p_sel = p[..., :n_sel].reshape(l_sel.shape)
        return (jnp.einsum('bkgqsn,bkgqsnd->bkgqd', p_sel, vs)
                + jnp.einsum('bkgqn,bknd->bkgqd', p[..., n_sel:], v_own))

    out = lax.map(one_chunk, (jnp.arange(nq), qc))
    return out.transpose(1, 0, 4, 2, 3, 5).reshape(B, S, H * dh)


def even_mixer(h, w_in, conv_w, sinks, w_out, table):
    B, S, _ = h.shape
    z = h @ w_in
    c1 = CONV_CH
    c2 = 2 * CONV_CH
    c3 = 3 * CONV_CH
    c4 = c3 + SWA_Q_W
    c5 = c4 + SWA_KV_W
    b_gate, c_gate, u, q, k, v = jnp.split(z, [c1, c2, c3, c4, c5], axis=-1)
    ya = short_conv_mixer(b_gate, c_gate, u, conv_w)
    yb = sliding_window_attention(q.reshape(B, S, SWA_HEADS, SWA_HEAD_DIM),
                                  k.reshape(B, S, SWA_KV_HEADS, SWA_HEAD_DIM),
                                  v.reshape(B, S, SWA_KV_HEADS, SWA_HEAD_DIM), sinks, table)
    return jnp.concatenate([ya, yb], axis=-1) @ w_out


def odd_mixer(h, w_in, w_out, table):
    B, S, _ = h.shape
    z = h @ w_in
    q, k, v = jnp.split(z, [MOBA_Q_W, MOBA_Q_W + MOBA_KV_W], axis=-1)
    y = moba_attention(q.reshape(B, S, MOBA_HEADS, MOBA_HEAD_DIM),
                       k.reshape(B, S, MOBA_KV_HEADS, MOBA_HEAD_DIM),
                       v.reshape(B, S, MOBA_KV_HEADS, MOBA_HEAD_DIM), table)
    return y @ w_out


def memory_cross_attention(h, mem_n, w_q, w_kv, w_o):
    B, S, _ = h.shape
    M = mem_n.shape[1]
    q = (h @ w_q).reshape(B, S, XA_HEADS, XA_HEAD_DIM)
    kv = (mem_n @ w_kv).reshape(B, M, 2, XA_HEADS, XA_HEAD_DIM)
    k, v = kv[:, :, 0], kv[:, :, 1]
    logits = jnp.einsum('bshd,bmhd->bhsm', q, k).astype(jnp.float32) * XA_HEAD_DIM ** -0.5
    p = jax.nn.softmax(logits, axis=-1).astype(v.dtype)
    o = jnp.einsum('bhsm,bmhd->bshd', p, v).reshape(B, S, XA_W)
    return o @ w_o


def setup_inputs(seed: int = 0) -> dict:
    key = jax.random.key(seed)
    ks = jax.random.split(key, 32)
    f32 = jnp.float32

    def w(k, shape, fan_in):
        return jax.random.normal(k, shape, f32) * fan_in ** -0.5

    def gain(k, shape):
        return 1.0 + 0.02 * jax.random.normal(k, shape, f32)

    return {
        'x': jax.random.normal(ks[0], (BATCH, SEQ, D_MODEL), f32),
        'mem': jax.random.normal(ks[1], (BATCH, MEM_LEN, D_MODEL), f32),
        'ffn1_norm': gain(ks[2], (DEPTH, D_MODEL)),
        'ffn1_w_gate': w(ks[3], (DEPTH, D_MODEL, D_FF), D_MODEL),
        'ffn1_w_up': w(ks[4], (DEPTH, D_MODEL, D_FF), D_MODEL),
        'ffn1_w_down': w(ks[5], (DEPTH, D_FF, D_MODEL), D_FF),
        'mix_norm': gain(ks[6], (DEPTH, D_MODEL)),
        'ev_w_in': w(ks[7], (N_EVEN, D_MODEL, EVEN_IN), D_MODEL),
        'ev_conv_w': w(ks[8], (N_EVEN, CONV_WIDTH, CONV_CH), CONV_WIDTH),
        'ev_sinks': 0.5 * jax.random.normal(ks[9], (N_EVEN, SWA_HEADS), f32),
        'ev_w_out': w(ks[10], (N_EVEN, EVEN_MIX, D_MODEL), EVEN_MIX),
        'od_w_in': w(ks[11], (N_ODD, D_MODEL, ODD_IN), D_MODEL),
        'od_w_out': w(ks[12], (N_ODD, MOBA_Q_W, D_MODEL), MOBA_Q_W),
        'rel_bias': 0.2 * jax.random.normal(ks[13], (REL_BUCKETS, REL_HEADS), f32),
        'xa_norm': gain(ks[14], (DEPTH, D_MODEL)),
        'xa_w_q': w(ks[15], (DEPTH, D_MODEL, XA_W), D_MODEL),
        'xa_w_kv': w(ks[16], (DEPTH, D_MODEL, 2 * XA_W), D_MODEL),
        'xa_w_o': w(ks[17], (DEPTH, XA_W, D_MODEL), XA_W),
        'mem_norm': gain(ks[18], (D_MODEL,)),
        'ffn2_norm': gain(ks[19], (DEPTH, D_MODEL)),
        'ffn2_w_gate': w(ks[20], (DEPTH, D_MODEL, D_FF), D_MODEL),
        'ffn2_w_up': w(ks[21], (DEPTH, D_MODEL, D_FF), D_MODEL),
        'ffn2_w_down': w(ks[22], (DEPTH, D_FF, D_MODEL), D_FF),
        'final_norm': gain(ks[23], (D_MODEL,)),
    }


def reference(x, mem, ffn1_norm, ffn1_w_gate, ffn1_w_up, ffn1_w_down, mix_norm,
              ev_w_in, ev_conv_w, ev_sinks, ev_w_out, od_w_in, od_w_out, rel_bias,
              xa_norm, xa_w_q, xa_w_kv, xa_w_o, mem_norm,
              ffn2_norm, ffn2_w_gate, ffn2_w_up, ffn2_w_down, final_norm):
    mem_n = rmsnorm(mem, mem_norm)
    for l in range(DEPTH):
        x = x + 0.5 * swiglu(rmsnorm(x, ffn1_norm[l]), ffn1_w_gate[l], ffn1_w_up[l], ffn1_w_down[l])
        h = rmsnorm(x, mix_norm[l])
        if l % 2 == 0:
            i = l // 2
            x = x + even_mixer(h, ev_w_in[i], ev_conv_w[i], ev_sinks[i], ev_w_out[i], rel_bias)
        else:
            i = l // 2
            x = x + odd_mixer(h, od_w_in[i], od_w_out[i], rel_bias)
        x = x + memory_cross_attention(rmsnorm(x, xa_norm[l]), mem_n, xa_w_q[l], xa_w_kv[l], xa_w_o[l])
        x = x + 0.5 * swiglu(rmsnorm(x, ffn2_norm[l]), ffn2_w_gate[l], ffn2_w_up[l], ffn2_w_down[l])
    return rmsnorm(x, final_norm)
```

```cpp
#include <hip/hip_runtime.h>
#include <hip/hip_cooperative_groups.h>
#include <cstdio>
#include <cstdint>
namespace cg = cooperative_groups;
namespace pg8 {
#define PG8_LAS __attribute__((address_space(3)))
typedef unsigned short bf16_t;
typedef short bf16x8 __attribute__((ext_vector_type(8)));
typedef float f32x4 __attribute__((ext_vector_type(4)));
typedef unsigned u32x4 __attribute__((ext_vector_type(4)));
constexpr int BM = 256, BK = 64, HALF = 128, HTB = HALF * BK * 2  , STAGE_BYTES = 8 * HTB, NXCD = 8, WGM = 8;

__host__ __device__ __forceinline__ int lds_byte(int r, int c) { const int st = (r >> 4) * 2 + (c >> 5), rr = r & 15, cc = c & 31, ob = rr * 64 + cc * 2; return st * 1024 + (ob ^ (((ob >> 9) & 1) << 5)); }
__host__ __device__ __forceinline__ void stage_rc(int b, int& R, int& C) { const int st = b / 1024, sb = b % 1024, swz = sb ^ (((sb >> 9) & 1) << 5); R = (st >> 1) * 16 + swz / 64; C = (st & 1) * 32 + (swz % 64) / 2; }
__host__ __device__ __forceinline__ int perm32(int rho) { const int n = rho >> 4, i = rho & 15; return 8 * (i >> 2) + 4 * n + (i & 3); }

struct Unit { int pm, pn; };
struct Gemm { const bf16_t* A; const bf16_t* Bt; int M, N, K; };

struct StaticOrder {
    int nM, nN, nwg, G, c;
    __host__ __device__ void init(int M, int N, int G_, int c_) { nM = M / BM; nN = N / BM; nwg = nM * nN; G = G_; c = c_; }
    __host__ __device__ bool next(int i, Unit& u) const {
        const long L = (long)i * G + c; if (L >= nwg) return false;
        int wgid = (int)L; { const int q = nwg / NXCD, r = nwg % NXCD, xcd = wgid % NXCD, off = wgid / NXCD; wgid = (xcd < r ? xcd * (q + 1) : r * (q + 1) + (xcd - r) * q) + off; }
        const int nig = WGM * nN, gid = wgid / nig, fm = gid * WGM, gsz = (nM - fm) < WGM ? (nM - fm) : WGM;
        u.pm = fm + ((wgid % nig) % gsz); u.pn = (wgid % nig) / gsz; return true;
    }
    __device__ __forceinline__ void a_ready(const Unit&) const {}
    __device__ __forceinline__ void done(const Unit&) const {}
};

__device__ __forceinline__ unsigned cvt_pk_bf16(float lo, float hi) { unsigned r; asm volatile("v_cvt_pk_bf16_f32 %0, %1, %2" : "=v"(r) : "v"(lo), "v"(hi)); return r; }
constexpr float RMS_EPS = 1e-6f;
__device__ __forceinline__ float row_rs(const float* ssp, int row) { const unsigned long long v = ((const unsigned long long*)ssp)[row];
    return __builtin_amdgcn_rsqf((float)v * (1.0f / 4294967296.0f) * (1.0f / 1024.0f) + RMS_EPS); }
__device__ __forceinline__ void fx_add(float* p, size_t idx, float s) { atomicAdd((unsigned long long*)p + idx, (unsigned long long)(long long)(s * 4294967296.0f)); }
typedef float f32x2v_ __attribute__((ext_vector_type(2))); typedef __bf16 bf16x2v_ __attribute__((ext_vector_type(2)));
__device__ __forceinline__ unsigned cvtpk(float lo, float hi) { f32x2v_ v = {lo, hi}; bf16x2v_ b = __builtin_convertvector(v, bf16x2v_); return __builtin_bit_cast(unsigned, b); }
struct EpiSwiglu {
    static constexpr bool PERM = true, AFTER_DRAIN = false;
    bf16_t* H; int ldh; const float* ss;
    __device__ __forceinline__ void operator()(const f32x4 (&acc)[2][2][4][2], const Unit& u, int wr, int wc, int fr, int fq) const {
        const int row0 = u.pm * BM + wr * 64 + fr, col0 = u.pn * HALF + wc * 32 + 8 * fq;
        float rsv[8];
#pragma unroll
        for (int k = 0; k < 8; ++k) rsv[k] = row_rs(ss, row0 + (k >> 2) * HALF + (k & 3) * 16);
#pragma unroll
        for (int ai = 0; ai < 2; ++ai)
#pragma unroll
            for (int m = 0; m < 4; ++m) { const int row = row0 + ai * HALF + m * 16; const float rs = rsv[ai * 4 + m];
                float hv[8];
#pragma unroll
                for (int n = 0; n < 2; ++n)
#pragma unroll
                    for (int i = 0; i < 4; ++i) { const float g = acc[ai][0][m][n][i] * rs, uu = acc[ai][1][m][n][i] * rs;
                        hv[n * 4 + i] = g * __builtin_amdgcn_rcpf(1.0f + __expf(-g)) * uu; }
                u32x4 w; w.x = cvtpk(hv[0], hv[1]); w.y = cvtpk(hv[2], hv[3]); w.z = cvtpk(hv[4], hv[5]); w.w = cvtpk(hv[6], hv[7]);
                *(u32x4*)(H + (size_t)row * ldh + col0) = w; }
    }
};
struct EpiScaleBf16 {
    static constexpr bool PERM = true, AFTER_DRAIN = false;
    bf16_t* O; int ldc; const float* ss;
    __device__ __forceinline__ void operator()(const f32x4 (&acc)[2][2][4][2], const Unit& u, int wr, int wc, int fr, int fq) const {
        const int row0 = u.pm * BM + wr * 64 + fr, col0 = u.pn * BM + wc * 32 + 8 * fq;
        float rsv[8];
#pragma unroll
        for (int k = 0; k < 8; ++k) rsv[k] = ss ? row_rs(ss, row0 + (k >> 2) * HALF + (k & 3) * 16) : 1.0f;
#pragma unroll
        for (int ai = 0; ai < 2; ++ai)
#pragma unroll
            for (int m = 0; m < 4; ++m) { const int row = row0 + ai * HALF + m * 16; const float rs = rsv[ai * 4 + m];
#pragma unroll
                for (int bj = 0; bj < 2; ++bj) { const f32x4 v0 = acc[ai][bj][m][0] * rs, v1 = acc[ai][bj][m][1] * rs;
                    u32x4 w; w.x = cvtpk(v0[0], v0[1]); w.y = cvtpk(v0[2], v0[3]); w.z = cvtpk(v1[0], v1[1]); w.w = cvtpk(v1[2], v1[3]);
                    *(u32x4*)(O + (size_t)row * ldc + col0 + bj * HALF) = w; } }
    }
};
struct EpiResid {
    static constexpr bool PERM = true, AFTER_DRAIN = false;
    const float* xin32; bf16_t* xb; float* ssout; float alpha;
    __device__ __forceinline__ void operator()(const f32x4 (&acc)[2][2][4][2], const Unit& u, int wr, int wc, int fr, int fq) const {
        const int row0 = u.pm * BM + wr * 64 + fr, col0 = u.pn * BM + wc * 32 + 8 * fq;
#pragma unroll
        for (int ai = 0; ai < 2; ++ai) {
            f32x4 a0[4][2], a1[4][2];
            if (xin32) {
#pragma unroll
                for (int m = 0; m < 4; ++m)
#pragma unroll
                    for (int bj = 0; bj < 2; ++bj) { const float* p = xin32 + (size_t)(row0 + ai * HALF + m * 16) * 1024 + col0 + bj * HALF; a0[m][bj] = *(const f32x4*)p; a1[m][bj] = *(const f32x4*)(p + 4); }
            } else {
                u32x4 w[4][2];
#pragma unroll
                for (int m = 0; m < 4; ++m)
#pragma unroll
                    for (int bj = 0; bj < 2; ++bj) w[m][bj] = *(const u32x4*)(xb + (size_t)(row0 + ai * HALF + m * 16) * 1024 + col0 + bj * HALF);
#pragma unroll
                for (int m = 0; m < 4; ++m)
#pragma unroll
                    for (int bj = 0; bj < 2; ++bj) { const u32x4 x = w[m][bj];
                        a0[m][bj] = (f32x4){__uint_as_float(x.x << 16), __uint_as_float(x.x & 0xffff0000u), __uint_as_float(x.y << 16), __uint_as_float(x.y & 0xffff0000u)};
                        a1[m][bj] = (f32x4){__uint_as_float(x.z << 16), __uint_as_float(x.z & 0xffff0000u), __uint_as_float(x.w << 16), __uint_as_float(x.w & 0xffff0000u)}; }
            }
#pragma unroll
            for (int m = 0; m < 4; ++m) { const int row = row0 + ai * HALF + m * 16; const size_t off = (size_t)row * 1024 + col0; float s = 0.f;
#pragma unroll
                for (int bj = 0; bj < 2; ++bj) {
                    const f32x4 v0 = a0[m][bj] + acc[ai][bj][m][0] * alpha, v1 = a1[m][bj] + acc[ai][bj][m][1] * alpha;
                    u32x4 w; w.x = cvtpk(v0[0], v0[1]); w.y = cvtpk(v0[2], v0[3]); w.z = cvtpk(v1[0], v1[1]); w.w = cvtpk(v1[2], v1[3]);
                    *(u32x4*)(xb + off + bj * HALF) = w;
                    s += (v0[0] * v0[0] + v0[1] * v0[1]) + (v0[2] * v0[2] + v0[3] * v0[3]) + (v1[0] * v1[0] + v1[1] * v1[1]) + (v1[2] * v1[2] + v1[3] * v1[3]); }
                s += __shfl_xor(s, 16); s += __shfl_xor(s, 32);
                if (fq == 0) fx_add(ssout, row, s); }
        }
    }
};
struct EpiQKV {
    static constexpr bool PERM = true, AFTER_DRAIN = false;
    bf16_t* O; int ldc; const float* ss; bf16_t* KP; bf16_t* VP; int kbeg, vbeg, dh_shift, kvh, S_shift; float* ksum;
    __device__ __forceinline__ void operator()(const f32x4 (&acc)[2][2][4][2], const Unit& u, int wr, int wc, int fr, int fq) const {
        const int row0 = u.pm * BM + wr * 64 + fr; const int DH = 1 << dh_shift;
        float rsv[8];
#pragma unroll
        for (int k = 0; k < 8; ++k) rsv[k] = ss ? row_rs(ss, row0 + (k >> 2) * HALF + (k & 3) * 16) : 1.0f;
#pragma unroll
        for (int bj = 0; bj < 2; ++bj) {
            const int cbase = u.pn * BM + bj * HALF, c0 = cbase + wc * 32 + 8 * fq;
            if (cbase < kbeg) {
#pragma unroll
                for (int ai = 0; ai < 2; ++ai)
#pragma unroll
                    for (int m = 0; m < 4; ++m) { const int row = row0 + ai * HALF + m * 16; const float rs = rsv[ai * 4 + m];
                        const f32x4 v0 = acc[ai][bj][m][0] * rs, v1 = acc[ai][bj][m][1] * rs;
                        u32x4 w; w.x = cvtpk(v0[0], v0[1]); w.y = cvtpk(v0[2], v0[3]); w.z = cvtpk(v1[0], v1[1]); w.w = cvtpk(v1[2], v1[3]);
                        *(u32x4*)(O + (size_t)row * ldc + c0) = w; }
            } else if (cbase < vbeg) {
                const int c = c0 - kbeg, head = c >> dh_shift, d = c & (DH - 1);
                float cs[8];
#pragma unroll
                for (int e = 0; e < 8; ++e) cs[e] = 0.f;
#pragma unroll
                for (int ai = 0; ai < 2; ++ai)
#pragma unroll
                    for (int m = 0; m < 4; ++m) { const int row = row0 + ai * HALF + m * 16; const float rs = rsv[ai * 4 + m];
                        const f32x4 v0 = acc[ai][bj][m][0] * rs, v1 = acc[ai][bj][m][1] * rs;
                        const int b = row >> S_shift, pos = row & ((1 << S_shift) - 1);
                        const size_t tile = ((size_t)(b * kvh + head) << (S_shift - 5)) + (pos >> 5);
                        u32x4 w; w.x = cvtpk(v0[0], v0[1]); w.y = cvtpk(v0[2], v0[3]); w.z = cvtpk(v1[0], v1[1]); w.w = cvtpk(v1[2], v1[3]);
                        *(u32x4*)(KP + tile * (size_t)(32 * DH) + ((d >> 3) * 32 + (pos & 31)) * 8) = w;
#pragma unroll
                        for (int e = 0; e < 4; ++e) { cs[e] += v0[e]; cs[4 + e] += v1[e]; } }
                if (ksum) {
#pragma unroll
                    for (int e = 0; e < 8; ++e) { float s = cs[e]; s += __shfl_xor(s, 1); s += __shfl_xor(s, 2); s += __shfl_xor(s, 4); s += __shfl_xor(s, 8); cs[e] = s; }
                    if (fr == 0) { const int rowb = u.pm * BM; const int b = rowb >> S_shift, blk = (rowb & ((1 << S_shift) - 1)) >> 8;
                        const size_t kd = ((size_t)((b * kvh + head) << (S_shift - 8)) + blk) * DH + d;
#pragma unroll
                        for (int e = 0; e < 8; ++e) fx_add(ksum, kd + e, cs[e]); }
                }
            } else {
                const int c = c0 - vbeg, head = c >> dh_shift, d = c & (DH - 1);
#pragma unroll
                for (int ai = 0; ai < 2; ++ai)
#pragma unroll
                    for (int m = 0; m < 4; ++m) { const int row = row0 + ai * HALF + m * 16; const float rs = rsv[ai * 4 + m];
                        const f32x4 v0 = acc[ai][bj][m][0] * rs, v1 = acc[ai][bj][m][1] * rs;
                        const int b = row >> S_shift, pos = row & ((1 << S_shift) - 1);
                        const size_t tile = ((size_t)(b * kvh + head) << (S_shift - 5)) + (pos >> 5);
                        bf16_t* vp = VP + tile * (size_t)(32 * DH) + ((((pos & 31) >> 3) << dh_shift) + d) * 8 + (pos & 7);
                        const unsigned w0 = cvtpk(v0[0], v0[1]), w1 = cvtpk(v0[2], v0[3]), w2 = cvtpk(v1[0], v1[1]), w3 = cvtpk(v1[2], v1[3]);
                        vp[0] = (bf16_t)(w0 & 0xffffu); vp[8] = (bf16_t)(w0 >> 16); vp[16] = (bf16_t)(w1 & 0xffffu); vp[24] = (bf16_t)(w1 >> 16);
                        vp[32] = (bf16_t)(w2 & 0xffffu); vp[40] = (bf16_t)(w2 >> 16); vp[48] = (bf16_t)(w3 & 0xffffu); vp[56] = (bf16_t)(w3 >> 16); }
            }
        }
    }
};
template <class Epi, class Sched, bool ALIGN_EPI = false, bool SP2 = false>
__device__ __forceinline__ void gemm_phase(PG8_LAS unsigned char* lds, const Gemm g, const Sched& S, const Epi& E) {
    int tid_ = threadIdx.x; asm volatile("" : "+v"(tid_));
    const int tid = tid_, wid = __builtin_amdgcn_readfirstlane(tid >> 6), lane = tid & 63, wr = wid >> 2, wc = wid & 3, fr = lane & 15, fq = lane >> 4;
    const int K = g.K, nt = K / BK;
    unsigned voffA[2], voffB[2];
#pragma unroll
    for (int i = 0; i < 2; ++i) { int R, C; stage_rc(tid * 16 + i * 8192, R, C); const int Rb = Epi::PERM ? ((R & ~31) + perm32(R & 31)) : R;
        voffA[i] = (unsigned)(R * K + C) * 2u; voffB[i] = (unsigned)(Rb * K + C) * 2u; }
    const size_t kstep = (size_t)(BK * 2);
    const size_t hstep = (size_t)HALF * K * 2;
    const size_t tstep = 2 * hstep;
    const unsigned ldsw = (unsigned)wid * 1024u;
    const int aoff = lds_byte(wr * 64 + fr, fq * 8), boff = lds_byte(wc * 32 + fr, fq * 8);
#define PG8_SA(b, h) (((b) * 2 + (h)) * HTB)
#define PG8_SB(b, h) ((4 + (b) * 2 + (h)) * HTB)
#define PG8_STAGE(bufoff, gbase, voff) do { _Pragma("unroll") for (int _i = 0; _i < 2; ++_i) \
        __builtin_amdgcn_global_load_lds((const unsigned*)((const char*)(gbase) + (voff)[_i]), (PG8_LAS unsigned*)(lds + (bufoff) + ldsw + _i * 8192), 16, 0, 0); } while (0)
#define PG8_LDA(dst, b, h) do { _Pragma("unroll") for (int m = 0; m < 4; ++m) _Pragma("unroll") for (int k = 0; k < 2; ++k) dst[m][k] = *(const PG8_LAS bf16x8*)(lds + PG8_SA(b, h) + aoff + m * 2048 + k * 1024); } while (0)
#define PG8_LDB(dst, b, h) do { _Pragma("unroll") for (int n = 0; n < 2; ++n) _Pragma("unroll") for (int k = 0; k < 2; ++k) dst[n][k] = *(const PG8_LAS bf16x8*)(lds + PG8_SB(b, h) + boff + n * 2048 + k * 1024); } while (0)
#define PG8_MMA(ai, bj, At, Bt) do { __builtin_amdgcn_s_setprio(1); _Pragma("unroll") for (int m = 0; m < 4; ++m) _Pragma("unroll") for (int n = 0; n < 2; ++n) _Pragma("unroll") for (int k = 0; k < 2; ++k) \
        acc[ai][bj][m][n] = __builtin_amdgcn_mfma_f32_16x16x32_bf16(Bt[n][k], At[m][k], acc[ai][bj][m][n], 0, 0, 0); __builtin_amdgcn_s_setprio(0); } while (0)
#define PG8_WAIT_V(n) asm volatile("s_waitcnt vmcnt(" #n ")" ::: "memory")
#define PG8_WAIT_L(n) asm volatile("s_waitcnt lgkmcnt(" #n ")" ::: "memory")
#define PG8_BAR __builtin_amdgcn_s_barrier()
#define PG8_SCHED __builtin_amdgcn_sched_barrier(0)
    Unit cur, nxt; int ui = 0;
    if (!S.next(0, cur)) return;
    f32x4 acc[2][2][4][2];
#pragma unroll
    for (int a = 0; a < 2; ++a)
#pragma unroll
        for (int b = 0; b < 2; ++b)
#pragma unroll
            for (int m = 0; m < 4; ++m)
#pragma unroll
                for (int n = 0; n < 2; ++n) acc[a][b][m][n] = (f32x4){0.f, 0.f, 0.f, 0.f};
    bf16x8 At[4][2], B0[2][2], B1[2][2];
    const char* cA = (const char*)g.A + (size_t)cur.pm * tstep; const char* cB = (const char*)g.Bt + (size_t)cur.pn * tstep;
    S.a_ready(cur);
    if constexpr (SP2) {
        PG8_STAGE(PG8_SB(0, 0), cB, voffB); PG8_STAGE(PG8_SB(0, 1), cB + hstep, voffB); PG8_STAGE(PG8_SA(0, 0), cA, voffA); PG8_STAGE(PG8_SA(0, 1), cA + hstep, voffA);
        if (wr == 1) PG8_BAR;
        PG8_WAIT_V(2); PG8_BAR;
        PG8_STAGE(PG8_SB(1, 0), cB + kstep, voffB); PG8_STAGE(PG8_SA(1, 0), cA + kstep, voffA); PG8_STAGE(PG8_SB(1, 1), cB + hstep + kstep, voffB);
        PG8_WAIT_V(6); PG8_BAR;
    } else {
        PG8_STAGE(PG8_SB(0, 0), cB, voffB); PG8_STAGE(PG8_SA(0, 0), cA, voffA); PG8_STAGE(PG8_SB(0, 1), cB + hstep, voffB); PG8_STAGE(PG8_SA(0, 1), cA + hstep, voffA);
        if (wr == 1) PG8_BAR;
        PG8_WAIT_V(4); PG8_BAR;
        PG8_STAGE(PG8_SB(1, 0), cB + kstep, voffB); PG8_STAGE(PG8_SA(1, 0), cA + kstep, voffA); PG8_STAGE(PG8_SB(1, 1), cB + hstep + kstep, voffB);
        PG8_WAIT_V(6); PG8_BAR;
    }
    for (;;) {
        const bool has_next = S.next(ui + 1, nxt);
        const char* nA = has_next ? (const char*)g.A + (size_t)nxt.pm * tstep : cA; const char* nB = has_next ? (const char*)g.Bt + (size_t)nxt.pn * tstep : cB;
        for (int t = 0; t < nt; t += 2) {
            const bool last = (t == nt - 2);
            const char* a1 = cA + (size_t)(t + 1) * kstep;
            const char* a2 = last ? nA : cA + (size_t)(t + 2) * kstep; const char* b2 = last ? nB : cB + (size_t)(t + 2) * kstep;
            const char* a3 = a2 + kstep; const char* b3 = b2 + kstep;
            if (last && has_next) S.a_ready(nxt);
            if constexpr (SP2) {
            PG8_LDB(B0, 0, 0); PG8_LDB(B1, 0, 1); PG8_SCHED; PG8_LDA(At, 0, 0); PG8_STAGE(PG8_SA(1, 1), a1 + hstep, voffA);
            PG8_WAIT_V(8); PG8_WAIT_L(0); PG8_BAR; PG8_MMA(0, 0, At, B0); PG8_MMA(0, 1, At, B1); PG8_BAR; PG8_SCHED;
            PG8_LDA(At, 0, 1); PG8_STAGE(PG8_SB(0, 0), b2, voffB); PG8_STAGE(PG8_SB(0, 1), b2 + hstep, voffB); PG8_STAGE(PG8_SA(0, 0), a2, voffA);
            PG8_WAIT_V(8); PG8_WAIT_L(0); PG8_BAR; PG8_MMA(1, 0, At, B0); PG8_MMA(1, 1, At, B1); PG8_BAR; PG8_SCHED;
            PG8_LDB(B0, 1, 0); PG8_LDB(B1, 1, 1); PG8_SCHED; PG8_LDA(At, 1, 0); PG8_STAGE(PG8_SA(0, 1), a2 + hstep, voffA);
            PG8_WAIT_V(8); PG8_WAIT_L(0); PG8_BAR; PG8_MMA(0, 0, At, B0); PG8_MMA(0, 1, At, B1); PG8_BAR; PG8_SCHED;
            PG8_LDA(At, 1, 1); PG8_STAGE(PG8_SB(1, 0), b3, voffB); PG8_STAGE(PG8_SB(1, 1), b3 + hstep, voffB); PG8_STAGE(PG8_SA(1, 0), a3, voffA);
            PG8_WAIT_V(8); PG8_WAIT_L(0); PG8_BAR; PG8_MMA(1, 0, At, B0); PG8_MMA(1, 1, At, B1); PG8_BAR; PG8_SCHED;
            } else {
            PG8_LDB(B0, 0, 0); PG8_SCHED; PG8_LDA(At, 0, 0); PG8_STAGE(PG8_SA(1, 1), a1 + hstep, voffA);
            PG8_WAIT_L(8); PG8_BAR; PG8_WAIT_L(0); PG8_MMA(0, 0, At, B0); PG8_BAR; PG8_SCHED;
            PG8_LDB(B1, 0, 1); PG8_STAGE(PG8_SB(0, 0), b2, voffB);
            PG8_BAR; PG8_WAIT_L(0); PG8_MMA(0, 1, At, B1); PG8_BAR;
            PG8_LDA(At, 0, 1); PG8_STAGE(PG8_SA(0, 0), a2, voffA);
            PG8_BAR; PG8_WAIT_L(0); PG8_MMA(1, 0, At, B0); PG8_BAR; PG8_SCHED;
            PG8_STAGE(PG8_SB(0, 1), b2 + hstep, voffB);
            PG8_WAIT_V(6); PG8_BAR; PG8_MMA(1, 1, At, B1); PG8_BAR;
            PG8_LDB(B0, 1, 0); PG8_SCHED; PG8_LDA(At, 1, 0); PG8_STAGE(PG8_SA(0, 1), a2 + hstep, voffA);
            PG8_WAIT_L(8); PG8_BAR; PG8_WAIT_L(0); PG8_MMA(0, 0, At, B0); PG8_BAR; PG8_SCHED;
            PG8_LDB(B1, 1, 1); PG8_STAGE(PG8_SB(1, 0), b3, voffB);
            PG8_BAR; PG8_WAIT_L(0); PG8_MMA(0, 1, At, B1); PG8_BAR;
            PG8_LDA(At, 1, 1); PG8_STAGE(PG8_SA(1, 0), a3, voffA);
            PG8_BAR; PG8_WAIT_L(0); PG8_MMA(1, 0, At, B0); PG8_BAR; PG8_SCHED;
            PG8_STAGE(PG8_SB(1, 1), b3 + hstep, voffB);
            PG8_WAIT_V(6); PG8_BAR; PG8_MMA(1, 1, At, B1); PG8_BAR;
            }
        }
        if constexpr (ALIGN_EPI) { if (wr == 0) PG8_BAR; }
        if constexpr (!Epi::AFTER_DRAIN) { E(acc, cur, wr, wc, fr, fq); S.done(cur); }
        if (!has_next) break;
#pragma unroll
        for (int a = 0; a < 2; ++a)
#pragma unroll
            for (int b = 0; b < 2; ++b)
#pragma unroll
                for (int m = 0; m < 4; ++m)
#pragma unroll
                    for (int n = 0; n < 2; ++n) acc[a][b][m][n] = (f32x4){0.f, 0.f, 0.f, 0.f};
        cur = nxt; cA = nA; cB = nB; ++ui;
        if constexpr (ALIGN_EPI) { if (wr == 1) PG8_BAR; }
    }
    PG8_WAIT_V(0);
    if constexpr (!ALIGN_EPI) { if (wr == 0) PG8_BAR; }
    PG8_BAR;
    if constexpr (Epi::AFTER_DRAIN) { E.fused(acc, cur, wr, wc, fr, fq, lds, wid, lane); S.done(cur); }
#undef PG8_SA
#undef PG8_SB
#undef PG8_STAGE
#undef PG8_LDA
#undef PG8_LDB
#undef PG8_MMA
#undef PG8_WAIT_V
#undef PG8_WAIT_L
#undef PG8_BAR
#undef PG8_SCHED
}
}
#ifndef DUPMASK
#define DUPMASK 0
#endif
#define NREP(k) (1 + ((DUPMASK >> (k)) & 1))
#define GSYNC() do { for (int rs_ = 0; rs_ < NREP(9); ++rs_) xcd_barrier(bar); } while (0)
constexpr int NWAVES = 8;
constexpr int T = 32768, D = 1024, FF = 2816, SEQ = 4096, NBATCH = 8, MEMLEN = 256, MEMROWS = NBATCH * MEMLEN;
constexpr int EV_IN = 2304, OD_IN = 2048, XAW = 512;
#define GAS __attribute__((address_space(1)))
#define LAS __attribute__((address_space(3)))
typedef unsigned short bf16;
typedef unsigned v4u __attribute__((ext_vector_type(4)));
typedef unsigned v2u __attribute__((ext_vector_type(2)));
typedef float f32x4 __attribute__((ext_vector_type(4)));
#define LDS_WAIT() asm volatile("s_waitcnt lgkmcnt(0)" ::: "memory")
__device__ __forceinline__ unsigned f2bf(float f) { unsigned u = __builtin_bit_cast(unsigned, f); return (u + 0x7fffu + ((u >> 16) & 1u)) >> 16; }
__device__ __forceinline__ unsigned pk2(float lo, float hi) { return f2bf(lo) | (f2bf(hi) << 16); }
__device__ __forceinline__ float bflo(unsigned w) { return __uint_as_float(w << 16); }
__device__ __forceinline__ float bfhi(unsigned w) { return __uint_as_float(w & 0xffff0000u); }
__device__ __forceinline__ float bf1(bf16 b) { return __uint_as_float((unsigned)b << 16); }
__device__ __forceinline__ float wave_sum(float v) {
#pragma unroll
    for (int o = 1; o < 64; o <<= 1) v += __shfl_xor(v, o);
    return v;
}
__device__ __forceinline__ int rel_bucket(int n) {
    if (n < 16) return n;
    int b = 16;
    b += (n >= 19); b += (n >= 21); b += (n >= 24); b += (n >= 27); b += (n >= 31); b += (n >= 35); b += (n >= 40); b += (n >= 46);
    b += (n >= 52); b += (n >= 59); b += (n >= 67); b += (n >= 77); b += (n >= 87); b += (n >= 99); b += (n >= 113);
    return b;
}

constexpr size_t MiB = 1u << 20;
constexpr size_t WS_TAB = 0;
constexpr int TABW = 256, TPAD = 32;
constexpr size_t WS_KSUM = 64 * 1024;
constexpr size_t WS_BAR = 16 * 1024;
constexpr size_t WS_SS = 448 * MiB;
constexpr size_t WS_W = 4 * MiB;
constexpr size_t W_GU = (size_t)2 * FF * D, W_DN = (size_t)D * FF;
constexpr size_t WO_GU1 = 0, WO_DN1 = WO_GU1 + 2 * W_GU, WO_GU2 = WO_DN1 + 2 * W_DN, WO_DN2 = WO_GU2 + 2 * W_GU;
constexpr size_t WO_EVIN = WO_DN2 + 2 * W_DN, WO_EVOUT = WO_EVIN + (size_t)EV_IN * D, WO_ODIN = WO_EVOUT + (size_t)D * D, WO_ODOUT = WO_ODIN + (size_t)OD_IN * D;
constexpr size_t WO_XQ = WO_ODOUT + (size_t)D * D, WO_XKV = WO_XQ + 2 * (size_t)XAW * D, WO_XO = WO_XKV + (size_t)2 * 1024 * D, WO_END = WO_XO + 2 * (size_t)D * XAW;
static_assert(WO_END * 2 <= 96 * MiB, "weights fit");
constexpr size_t WS_MEMN = 100 * MiB;
constexpr size_t WS_XKP = 104 * MiB, WS_XVP = 108 * MiB;
constexpr size_t WS_XB = 112 * MiB;
constexpr size_t WS_Y = 176 * MiB;
constexpr size_t WS_R1 = 240 * MiB;
constexpr size_t WS_XQ = WS_R1, WS_XO = WS_R1 + 32 * MiB;
constexpr size_t WS_KPAN = WS_R1 + 144 * MiB;
constexpr size_t WS_VPAN = WS_R1 + 176 * MiB;
constexpr size_t WS_END = WS_VPAN + 32 * MiB + 20 * MiB;
constexpr size_t WS_XDUMMY = WS_Y;

constexpr int LDS_BYTES = 147456, LDS_TAB_OFF = 131072, LDS_BARST_OFF = 131072 + 8192;

struct Args { const float* in[24]; float* out; unsigned char* ws; };

struct Job { const float* src; const float* gain; bf16* dst; int K, N, mode; };
__device__ __forceinline__ Job get_job(int j, const Args& a, bf16* W) {
    Job b; b.gain = nullptr; b.mode = 0;
    if (j < 18) { const int l = j / 9, r = j % 9;
        switch (r) {
        case 0: b.src = a.in[3] + (size_t)l * D * FF; b.gain = a.in[2] + l * D; b.dst = W + WO_GU1 + l * W_GU; b.K = D; b.N = FF; b.mode = 1; break;
        case 1: b.src = a.in[4] + (size_t)l * D * FF; b.gain = a.in[2] + l * D; b.dst = W + WO_GU1 + l * W_GU; b.K = D; b.N = FF; b.mode = 2; break;
        case 2: b.src = a.in[5] + (size_t)l * D * FF; b.dst = W + WO_DN1 + l * W_DN; b.K = FF; b.N = D; break;
        case 3: b.src = a.in[20] + (size_t)l * D * FF; b.gain = a.in[19] + l * D; b.dst = W + WO_GU2 + l * W_GU; b.K = D; b.N = FF; b.mode = 1; break;
        case 4: b.src = a.in[21] + (size_t)l * D * FF; b.gain = a.in[19] + l * D; b.dst = W + WO_GU2 + l * W_GU; b.K = D; b.N = FF; b.mode = 2; break;
        case 5: b.src = a.in[22] + (size_t)l * D * FF; b.dst = W + WO_DN2 + l * W_DN; b.K = FF; b.N = D; break;
        case 6: b.src = a.in[15] + (size_t)l * D * XAW; b.gain = a.in[14] + l * D; b.dst = W + WO_XQ + (size_t)l * XAW * D; b.K = D; b.N = XAW; break;
        case 7: b.src = a.in[16] + (size_t)l * D * 1024; b.dst = W + WO_XKV + (size_t)l * 1024 * D; b.K = D; b.N = 1024; break;
        default: b.src = a.in[17] + (size_t)l * XAW * D; b.dst = W + WO_XO + (size_t)l * D * XAW; b.K = XAW; b.N = D; break;
        }
    } else {
        switch (j) {
        case 18: b.src = a.in[7]; b.gain = a.in[6]; b.dst = W + WO_EVIN; b.K = D; b.N = EV_IN; break;
        case 19: b.src = a.in[10]; b.dst = W + WO_EVOUT; b.K = D; b.N = D; break;
        case 20: b.src = a.in[11]; b.gain = a.in[6] + D; b.dst = W + WO_ODIN; b.K = D; b.N = OD_IN; break;
        default: b.src = a.in[12]; b.dst = W + WO_ODOUT; b.K = D; b.N = D; break;
        }
    }
    return b;
}
__device__ __forceinline__ void transpose_item(const Job& jb, LAS float* scr, int item, int lane) {
    const int K = jb.K, N = jb.N; const int nblk = N / 32, kb = item / nblk, nb = item % nblk, k0 = 64 * kb, n0 = 32 * nb;
    int r0 = n0; if (jb.mode) r0 = 256 * (n0 / 128) + (n0 % 128) + (jb.mode == 2 ? 128 : 0);
#pragma unroll
    for (int i = 0; i < 8; ++i) { const int kk = 8 * i + (lane >> 3), c4 = 4 * (lane & 7); const float g = jb.gain ? jb.gain[k0 + kk] : 1.0f;
        const f32x4 v = *(const f32x4*)(jb.src + (size_t)(k0 + kk) * N + n0 + c4); LAS float* d = scr + kk * 33 + c4;
        d[0] = v.x * g; d[1] = v.y * g; d[2] = v.z * g; d[3] = v.w * g; }
    LDS_WAIT(); asm volatile("" ::: "memory");
    const int c = lane & 7;
#pragma unroll
    for (int j = 0; j < 4; ++j) { const int n = (lane >> 3) + 8 * j; const LAS float* s = scr + (8 * c) * 33 + n;
        v4u o; o.x = pk2(s[0 * 33], s[1 * 33]); o.y = pk2(s[2 * 33], s[3 * 33]); o.z = pk2(s[4 * 33], s[5 * 33]); o.w = pk2(s[6 * 33], s[7 * 33]);
        *(v4u*)(jb.dst + (size_t)(r0 + n) * K + k0 + 8 * c) = o; }
    LDS_WAIT(); asm volatile("" ::: "memory");
}
constexpr int N_JOB_ITEMS = 2 * (6 * 1408 + 256 + 512 + 256) + 1152 + 512 + 1024 + 512;


#define XB_TMO      128
#define XB_XCNT(j)  (256  + 64 * (j))
#define XB_XSUB(j)  (1280 + 64 * (j))
#define XB_XGEN(j)  (2304 + 64 * (j))
#define XB_TOP      3328
#define XB_TOPGEN   3392
#define XCD_BAR_WORDS 3456
#define XB_SPIN_CAP (1u << 18)

__device__ __forceinline__ unsigned xb_ld(unsigned* p)              { return __hip_atomic_load(p, __ATOMIC_RELAXED, __HIP_MEMORY_SCOPE_AGENT); }
__device__ __forceinline__ unsigned xb_add(unsigned* p, unsigned v) { return __hip_atomic_fetch_add(p, v, __ATOMIC_RELAXED, __HIP_MEMORY_SCOPE_AGENT); }
__device__ __forceinline__ unsigned xb_xcc_id() { return (unsigned)__builtin_amdgcn_s_getreg((3 << 11) | 20) & 0xFu; }
#define XB_SPIN(cond, bar) do { unsigned _sp = 0; while (cond) { __builtin_amdgcn_s_sleep(1); \
    if ((++_sp & 255u) == 0u) { if (xb_ld(&(bar)[XB_TMO])) break; if (_sp > XB_SPIN_CAP) { atomicAdd(&(bar)[XB_TMO], 1u); break; } } } } while (0)

struct XcdBarrier {
    unsigned* bar; unsigned x;
    volatile LAS unsigned* st;
};

__device__ __forceinline__ XcdBarrier xcd_barrier_post(unsigned* bar, volatile LAS unsigned* st) {
    XcdBarrier b; b.bar = bar; b.x = xb_xcc_id(); b.st = st;
    if (threadIdx.x == 0) (void)xb_add(&bar[XB_XCNT(b.x)], 1u);
    return b;
}
__device__ __forceinline__ void xcd_barrier_complete(unsigned* bar, unsigned x, unsigned& nloc, unsigned& nx) {
    const unsigned G = gridDim.x * gridDim.y * gridDim.z;
    unsigned sum, cnt, mine, sp = 0u;
    for (;;) {
        sum = 0u; cnt = 0u; mine = 0u;
#pragma unroll
        for (unsigned j = 0; j < 16; ++j) { const unsigned c = xb_ld(&bar[XB_XCNT(j)]); sum += c; cnt += (c > 0u) ? 1u : 0u; mine = (j == x) ? c : mine; }
        if (sum == G) break;
        __builtin_amdgcn_s_sleep(1);
        if ((++sp & 255u) == 0u) { if (xb_ld(&bar[XB_TMO])) break; if (sp > XB_SPIN_CAP) { atomicAdd(&bar[XB_TMO], 1u); break; } }
    }
    nloc = mine > 0u ? mine : 1u; nx = cnt > 0u ? cnt : 1u;
}

__device__ __forceinline__ void xcd_barrier(const XcdBarrier& b) {
    asm volatile("s_waitcnt vmcnt(0)" ::: "memory");
    __syncthreads();
    if (threadIdx.x == 0) {
        unsigned* bar = b.bar;
        __builtin_amdgcn_s_waitcnt(0);
        unsigned nloc = b.st[0], nx = b.st[1];
        if (nloc == 0u) { xcd_barrier_complete(bar, b.x, nloc, nx); b.st[0] = nloc; b.st[1] = nx; }
        const unsigned old = xb_add(&bar[XB_XSUB(b.x)], 1u);
        const unsigned gen = old / nloc;
        if (old + 1u == (gen + 1u) * nloc) {
            __builtin_amdgcn_fence(__ATOMIC_RELEASE, "agent");
            asm volatile("s_waitcnt vmcnt(0)" ::: "memory");
            const unsigned og = xb_add(&bar[XB_TOP], 1u);
            const unsigned tg = og / nx;
            if (og + 1u == (tg + 1u) * nx) xb_add(&bar[XB_TOPGEN], 1u);
            else XB_SPIN(xb_ld(&bar[XB_TOPGEN]) == tg, bar);
            __builtin_amdgcn_fence(__ATOMIC_ACQUIRE, "agent");
            xb_add(&bar[XB_XGEN(b.x)], 1u);
            asm volatile("s_waitcnt vmcnt(0)" ::: "memory");
        } else {
            XB_SPIN(xb_ld(&bar[XB_XGEN(b.x)]) == gen, bar);
            __builtin_amdgcn_fence(__ATOMIC_ACQUIRE, "agent");
            asm volatile("s_waitcnt vmcnt(0)" ::: "memory");
        }
    }
    __syncthreads();
}

typedef short bf16x8 __attribute__((ext_vector_type(8)));
typedef float f32x16 __attribute__((ext_vector_type(16)));
#define MFMA32(a, b, c) __builtin_amdgcn_mfma_f32_32x32x16_bf16((a), (b), (c), 0, 0, 0)
using pg8::cvtpk;
constexpr float LOG2E = 1.4426950408889634f;
__device__ __forceinline__ constexpr int kofs(int i) { return (i & 3) + 4 * ((i >> 2) & 1) + 16 * (i >> 3); }
template <int DH, class LF>
__device__ __forceinline__ void attn_run(const bf16* kb, const bf16* vb, int t0, int t1, const bf16x8 (&qf)[DH / 16], f32x16 (&o)[DH / 32], float& m_run, float& l_run, LF&& lf) {
    constexpr int KS = DH / 16, ND = DH / 32, TS = 32 * DH;
    bf16x8 kf[KS];
#pragma unroll
    for (int s = 0; s < KS; ++s) kf[s] = *(const bf16x8*)(kb + s * 512);
#pragma unroll 1
    for (int t = t0; t <= t1; ++t) {
        bf16x8 vf[2][ND];
#pragma unroll
        for (int s2 = 0; s2 < 2; ++s2)
#pragma unroll
            for (int dg = 0; dg < ND; ++dg) vf[s2][dg] = *(const bf16x8*)(vb + s2 * (2 * DH * 8) + dg * 256);
        f32x16 st;
#pragma unroll
        for (int i = 0; i < 16; ++i) st[i] = 0.f;
#pragma unroll
        for (int s = 0; s < KS; ++s) st = MFMA32(kf[s], qf[s], st);
        if (t < t1) kb += TS;
        vb += TS;
#pragma unroll
        for (int s = 0; s < KS; ++s) kf[s] = *(const bf16x8*)(kb + s * 512);
        lf(t, st);
        float tmax = fmaxf(fmaxf(st[0], st[1]), st[2]);
#pragma unroll
        for (int i = 3; i < 15; i += 2) tmax = fmaxf(fmaxf(tmax, st[i]), st[i + 1]);
        tmax = fmaxf(tmax, st[15]);
        { auto rr_ = __builtin_amdgcn_permlane32_swap(__float_as_uint(tmax), __float_as_uint(tmax), false, false); tmax = fmaxf(__uint_as_float(rr_[0]), __uint_as_float(rr_[1])); }
        if (__any(tmax > m_run + 8.0f)) {
            const float mn = fmaxf(m_run, tmax), corr = __builtin_amdgcn_exp2f(m_run - mn); m_run = mn; l_run *= corr;
#pragma unroll
            for (int dg = 0; dg < ND; ++dg) o[dg] = o[dg] * corr;
        }
        st = st - m_run;
#pragma unroll
        for (int i = 0; i < 16; ++i) st[i] = __builtin_amdgcn_exp2f(st[i]);
        { float ps = ((st[0] + st[1]) + (st[2] + st[3])) + ((st[4] + st[5]) + (st[6] + st[7])) + ((st[8] + st[9]) + (st[10] + st[11])) + ((st[12] + st[13]) + (st[14] + st[15]));
          { auto rr_ = __builtin_amdgcn_permlane32_swap(__float_as_uint(ps), __float_as_uint(ps), false, false); ps = __uint_as_float(rr_[0]) + __uint_as_float(rr_[1]); } l_run += ps; }
        v4u p0, p1; p0.x = cvtpk(st[0], st[1]); p0.y = cvtpk(st[2], st[3]); p0.z = cvtpk(st[4], st[5]); p0.w = cvtpk(st[6], st[7]);
        p1.x = cvtpk(st[8], st[9]); p1.y = cvtpk(st[10], st[11]); p1.z = cvtpk(st[12], st[13]); p1.w = cvtpk(st[14], st[15]);
        const bf16x8 pf0 = __builtin_bit_cast(bf16x8, p0), pf1 = __builtin_bit_cast(bf16x8, p1);
#pragma unroll
        for (int dg = 0; dg < ND; ++dg) { o[dg] = MFMA32(vf[0][dg], pf0, o[dg]); o[dg] = MFMA32(vf[1][dg], pf1, o[dg]); }
    }
}

template <int DH, class LF, class VF>
__device__ __forceinline__ void attn_tile_tail(int t, f32x16& st, f32x16 (&o)[DH / 32], float& m_run, float& l_run, LF&& lf, VF&& vfrag) {
    constexpr int ND = DH / 32;
    lf(t, st);
    for (int vr_ = 1; vr_ < NREP(13); ++vr_) { f32x16 d_ = st; asm volatile("" : "+v"(d_)); float dm_ = fmaxf(fmaxf(d_[0], d_[1]), d_[2]);
#pragma unroll
        for (int i = 3; i < 15; i += 2) dm_ = fmaxf(fmaxf(dm_, d_[i]), d_[i + 1]);
        dm_ = fmaxf(dm_, __shfl_xor(dm_, 32)); d_ = d_ - dm_;
#pragma unroll
        for (int i = 0; i < 16; ++i) d_[i] = __builtin_amdgcn_exp2f(d_[i]);
        float ds_ = 0.f;
#pragma unroll
        for (int i = 0; i < 16; ++i) ds_ += d_[i];
        ds_ += __shfl_xor(ds_, 32); unsigned dp_ = 0;
#pragma unroll
        for (int i = 0; i < 16; i += 2) dp_ ^= cvtpk(d_[i], d_[i + 1]);
        asm volatile("" :: "v"(ds_), "v"(dp_)); }
    float tmax = fmaxf(fmaxf(st[0], st[1]), st[2]);
#pragma unroll
    for (int i = 3; i < 15; i += 2) tmax = fmaxf(fmaxf(tmax, st[i]), st[i + 1]);
    tmax = fmaxf(tmax, st[15]);
    { auto rr_ = __builtin_amdgcn_permlane32_swap(__float_as_uint(tmax), __float_as_uint(tmax), false, false); tmax = fmaxf(__uint_as_float(rr_[0]), __uint_as_float(rr_[1])); }
    if (__any(tmax > m_run + 8.0f)) {
        const float mn = fmaxf(m_run, tmax), corr = __builtin_amdgcn_exp2f(m_run - mn); m_run = mn; l_run *= corr;
#pragma unroll
        for (int dg = 0; dg < ND; ++dg) o[dg] = o[dg] * corr;
    }
    st = st - m_run;
#pragma unroll
    for (int i = 0; i < 16; ++i) st[i] = __builtin_amdgcn_exp2f(st[i]);
    { float ps = ((st[0] + st[1]) + (st[2] + st[3])) + ((st[4] + st[5]) + (st[6] + st[7])) + ((st[8] + st[9]) + (st[10] + st[11])) + ((st[12] + st[13]) + (st[14] + st[15]));
      { auto rr_ = __builtin_amdgcn_permlane32_swap(__float_as_uint(ps), __float_as_uint(ps), false, false); ps = __uint_as_float(rr_[0]) + __uint_as_float(rr_[1]); } l_run += ps; }
    v4u p0, p1; p0.x = cvtpk(st[0], st[1]); p0.y = cvtpk(st[2], st[3]); p0.z = cvtpk(st[4], st[5]); p0.w = cvtpk(st[6], st[7]);
    p1.x = cvtpk(st[8], st[9]); p1.y = cvtpk(st[10], st[11]); p1.z = cvtpk(st[12], st[13]); p1.w = cvtpk(st[14], st[15]);
    const bf16x8 pf0 = __builtin_bit_cast(bf16x8, p0), pf1 = __builtin_bit_cast(bf16x8, p1);
#pragma unroll
    for (int dg = 0; dg < ND; ++dg) { o[dg] = MFMA32(vfrag(0, dg), pf0, o[dg]); o[dg] = MFMA32(vfrag(1, dg), pf1, o[dg]); }
    for (int pr_ = 1; pr_ < NREP(14); ++pr_) { bf16x8 z_ = {0, 0, 0, 0, 0, 0, 0, 0}; asm volatile("" : "+v"(z_));
#pragma unroll
        for (int dg = 0; dg < ND; ++dg) { o[dg] = MFMA32(vfrag(0, dg), z_, o[dg]); o[dg] = MFMA32(vfrag(1, dg), z_, o[dg]); } }
}
template <int DH>
__device__ __forceinline__ void attn_store(bf16* orow, const f32x16 (&o)[DH / 32], float l_run, int h) {
    const float il = 1.0f / l_run;
#pragma unroll
    for (int dg = 0; dg < DH / 32; ++dg)
#pragma unroll
        for (int g = 0; g < 4; g += 2) {
            unsigned ax = cvtpk(o[dg][4 * g] * il, o[dg][4 * g + 1] * il), ay = cvtpk(o[dg][4 * g + 2] * il, o[dg][4 * g + 3] * il);
            unsigned bx = cvtpk(o[dg][4 * g + 4] * il, o[dg][4 * g + 5] * il), by = cvtpk(o[dg][4 * g + 6] * il, o[dg][4 * g + 7] * il);
            { auto rr = __builtin_amdgcn_permlane32_swap(ax, bx, false, false); ax = rr[0]; bx = rr[1]; }
            { auto rr = __builtin_amdgcn_permlane32_swap(ay, by, false, false); ay = rr[0]; by = rr[1]; }
            v4u w; w.x = ax; w.y = ay; w.z = bx; w.w = by;
            *(v4u*)(orow + dg * 32 + 8 * g + 8 * h) = w; }
}
#define TOP3_INSERT(g, n) do { if ((g) > s0) { s2 = s1; i2 = i1; s1 = s0; i1 = i0; s0 = (g); i0 = (n); } else if ((g) > s1) { s2 = s1; i2 = i1; s1 = (g); i1 = (n); } else if ((g) > s2) { s2 = (g); i2 = (n); } } while (0)

__device__ __forceinline__ void build_bias_table(LAS unsigned char* lds, const float* rel_bias, bool window) {
    for (int i = threadIdx.x; i < 8 * TABW; i += NWAVES * 64) { const int h = i / TABW, k = i % TABW, d = k - TPAD;
        float v = -INFINITY;
        if (d >= 0 && d < 128) v = rel_bias[rel_bucket(d) * 8 + h] * LOG2E; else if (d >= 128 && !window) v = rel_bias[31 * 8 + h] * LOG2E;
        ((LAS float*)(lds + LDS_TAB_OFF))[i] = v; }
}
template <int l> __device__ __forceinline__ void layer_body(const Args& args, LAS unsigned char* lds, const XcdBarrier& bar) {
    int tid_ = threadIdx.x; asm volatile("" : "+v"(tid_));
    const int tid = tid_, lane = tid & 63, wave = __builtin_amdgcn_readfirstlane(tid >> 6);
    const int G = gridDim.x, bx = blockIdx.x;
    unsigned char* ws = args.ws;
    float* KSUM = (float*)(ws + WS_KSUM); float* SS = (float*)(ws + WS_SS);
    bf16* W = (bf16*)(ws + WS_W); bf16* XKP = (bf16*)(ws + WS_XKP); bf16* XVP = (bf16*)(ws + WS_XVP); bf16* KPAN = (bf16*)(ws + WS_KPAN); bf16* VPAN = (bf16*)(ws + WS_VPAN);
    const LAS float* tabl = (const LAS float*)(lds + LDS_TAB_OFF); const int r = lane & 31, hh = lane >> 5, pr = (r & ~12) | ((r & 4) << 1) | ((r & 8) >> 1);
    bf16* XB = (bf16*)(ws + WS_XB); bf16* Y = (bf16*)(ws + WS_Y); bf16* R1 = (bf16*)(ws + WS_R1); bf16* XQ = (bf16*)(ws + WS_XQ); bf16* XO = (bf16*)(ws + WS_XO);
    const float* x_in = args.in[0]; float* OUT = args.out;
        float* ssl = SS + (size_t)(4 * l) * T * 2; constexpr size_t TS16 = (size_t)T * 2;
        for (int rep = 0; rep < NREP(0); ++rep) { pg8::Gemm g{XB, W + WO_GU1 + l * W_GU, T, 2 * FF, D}; pg8::StaticOrder S; S.init(T, 2 * FF, G, bx);
          pg8::EpiSwiglu E{R1, FF, ssl};
          pg8::gemm_phase<pg8::EpiSwiglu, pg8::StaticOrder, true, true>(lds, g, S, E); }
        GSYNC();
        for (int rep = 0; rep < NREP(1); ++rep) { const bool fin = rep == NREP(1) - 1; pg8::Gemm g{R1, W + WO_DN1 + l * W_DN, T, D, FF}; pg8::StaticOrder S; S.init(T, D, G, bx);
          pg8::EpiResid E{l == 0 ? x_in : nullptr, XB, fin ? ssl + TS16 : SS + 9 * TS16, fin ? 0.5f : 0.0f};
          pg8::gemm_phase<pg8::EpiResid, pg8::StaticOrder, true, true>(lds, g, S, E); }
        GSYNC();
        const int NIN = (l == 0) ? EV_IN : OD_IN;
        for (int rep = 0; rep < NREP(2); ++rep) { pg8::Gemm g{XB, W + (l == 0 ? WO_EVIN : WO_ODIN), T, NIN, D}; pg8::StaticOrder S; S.init(T, NIN, G, bx);
          pg8::EpiQKV E{R1, NIN, ssl + TS16, KPAN, VPAN, l == 0 ? 2048 : 1024, l == 0 ? 2176 : 1536, l == 0 ? 6 : 7, l == 0 ? 2 : 4, 12, l == 0 ? nullptr : KSUM};
          pg8::gemm_phase<pg8::EpiQKV, pg8::StaticOrder, true, true>(lds, g, S, E); }
        if (l == 0) {
#pragma unroll
            for (int lk = 0; lk < 2; ++lk) { pg8::Gemm g{(const bf16*)(ws + WS_MEMN), W + WO_XKV + (size_t)lk * 1024 * D, MEMROWS, 1024, D}; pg8::StaticOrder S; S.init(MEMROWS, 1024, G, (bx + G - (128 + 32 * lk) % G) % G);
              pg8::EpiQKV E{nullptr, 0, nullptr, XKP + (size_t)lk * 32 * 8 * 4096, XVP + (size_t)lk * 32 * 8 * 4096, 0, 512, 7, 4, 8, nullptr};
              pg8::gemm_phase<pg8::EpiQKV, pg8::StaticOrder, true, true>(lds, g, S, E); }
        }
        GSYNC();
        if (l == 0) {
            const bf16* Z = R1; const float* cw = args.in[8];
            for (int rep = 0; rep < NREP(3); ++rep) for (int w = bx; w < T / 128; w += G) {
                { const int c = (tid & 63) * 8;
                  const f32x4 wa0 = *(const f32x4*)(cw + c), wa1 = *(const f32x4*)(cw + c + 4), wb0 = *(const f32x4*)(cw + 512 + c), wb1 = *(const f32x4*)(cw + 512 + c + 4), wc0 = *(const f32x4*)(cw + 1024 + c), wc1 = *(const f32x4*)(cw + 1024 + c + 4);
#define CONV2(k, W0a, W0b, W1a, W1b, W2a, W2b) cvtpk(bflo(bg[q_][k]) * ((W2a) * bflo(c0[q_][k]) * bflo(u0[q_][k]) + (W1a) * bflo(c1[q_][k]) * bflo(u1[q_][k]) + (W0a) * bflo(c2[q_][k]) * bflo(u2[q_][k])), \
                                                      bfhi(bg[q_][k]) * ((W2b) * bfhi(c0[q_][k]) * bfhi(u0[q_][k]) + (W1b) * bfhi(c1[q_][k]) * bfhi(u1[q_][k]) + (W0b) * bfhi(c2[q_][k]) * bfhi(u2[q_][k])))
                  for (int i = 0; i < 16; i += 2) { v4u bg[2], c0[2], u0[2], c1[2], u1[2], c2[2], u2[2];
#pragma unroll
                    for (int q_ = 0; q_ < 2; ++q_) { const int t = w * 128 + (tid >> 6) + 8 * (i + q_), pos = t & (SEQ - 1); const bf16* zr = Z + (size_t)t * EV_IN + c;
                        bg[q_] = *(const v4u*)zr; c0[q_] = *(const v4u*)(zr + 512); u0[q_] = *(const v4u*)(zr + 1024);
                        c1[q_] = (v4u){0, 0, 0, 0}; u1[q_] = (v4u){0, 0, 0, 0}; c2[q_] = (v4u){0, 0, 0, 0}; u2[q_] = (v4u){0, 0, 0, 0};
                        if (pos >= 1) { c1[q_] = *(const v4u*)(zr + 512 - EV_IN); u1[q_] = *(const v4u*)(zr + 1024 - EV_IN); }
                        if (pos >= 2) { c2[q_] = *(const v4u*)(zr + 512 - 2 * EV_IN); u2[q_] = *(const v4u*)(zr + 1024 - 2 * EV_IN); } }
#pragma unroll
                    for (int q_ = 0; q_ < 2; ++q_) { const int t = w * 128 + (tid >> 6) + 8 * (i + q_); v4u o;
                        o.x = CONV2(0, wa0[0], wa0[1], wb0[0], wb0[1], wc0[0], wc0[1]); o.y = CONV2(1, wa0[2], wa0[3], wb0[2], wb0[3], wc0[2], wc0[3]);
                        o.z = CONV2(2, wa1[0], wa1[1], wb1[0], wb1[1], wc1[0], wc1[1]); o.w = CONV2(3, wa1[2], wa1[3], wb1[2], wb1[3], wc1[2], wc1[3]);
                        *(v4u*)(Y + (size_t)t * D + c) = o; } }
#undef CONV2
                }
                const int hd = wave, kvh = hd >> 2; const float sink2 = args.in[9][hd] * LOG2E; const LAS float* tb = tabl + hd * TABW;
                for (int jj = 0; jj < 4; ++jj) { const int qt = w * 4 + jj, b = qt >> 7, j = qt & 127, q0g = qt * 32;
                    bf16x8 qf[4];
#pragma unroll
                    for (int s = 0; s < 4; ++s) qf[s] = *(const bf16x8*)(Z + (size_t)(q0g + r) * EV_IN + 1536 + hd * 64 + 16 * s + 8 * hh);
                    f32x16 o[2];
#pragma unroll
                    for (int i = 0; i < 16; ++i) { o[0][i] = 0.f; o[1][i] = 0.f; }
                    float m_run = sink2, l_run = 1.0f;
                    const int t0 = j >= 4 ? j - 4 : 0; const size_t tb0 = ((size_t)(b * 2 + kvh) * 128 + t0) * 2048;
                    const int qpos = j * 32 + r;
                    attn_run<64>(KPAN + tb0 + (hh * 32 + pr) * 8, VPAN + tb0 + (hh * 64 + r) * 8, t0, j, qf, o, m_run, l_run, [&](int t, f32x16& st) {
                        const LAS float* bp = tb + (TPAD - 23) + (qpos - t * 32 - 8 * hh);
#pragma unroll
                        for (int i = 0; i < 16; ++i) st[i] = __builtin_fmaf(st[i], 0.125f * LOG2E, bp[23 - kofs(i)]); });
                    attn_store<64>(Y + (size_t)(q0g + r) * D + 512 + hd * 64, o, l_run, hh); }
            }
        } else {
            const bf16* Z = R1;
            build_bias_table(lds, args.in[13], false); __syncthreads();
            const LAS float* tb0_ = tabl; const float scale2 = 0.08838834764831845f * LOG2E;
            for (int rep = 0; rep < NREP(4); ++rep) for (int w = bx; w < 256; w += G) { const int b = w & 7, kvh = (w >> 3) & 3, uu = w >> 5;
                for (int jj = 0; jj < 4; ++jj) { const int jg = (jj == 0) ? uu : (jj == 1) ? 15 - uu : (jj == 2) ? 16 + uu : 31 - uu;
                    const int j = jg * 4 + (wave >> 1), jmax = jg * 4 + 3, hd = kvh * 2 + (wave & 1), own = j >> 3, q0g = b * SEQ + j * 32;
                    const LAS float* tb = tb0_ + hd * TABW; const float b128 = tb[TPAD + 128];
                    const bf16* kgu = KPAN + (size_t)(b * 4 + kvh) * 128 * 4096; const bf16* vgu = VPAN + (size_t)(b * 4 + kvh) * 128 * 4096; const unsigned so = (unsigned)tid * 8u;
#define DMA16(gsrc, ldsoff) __builtin_amdgcn_global_load_lds((const unsigned*)(gsrc), (LAS unsigned*)(lds + (ldsoff) + wave * 1024), 16, 0, 0)
#define DMA_PAIR(u_, pb_) do { DMA16(kgu + (size_t)(2 * (u_)) * 4096 + so, (pb_)); DMA16(kgu + (size_t)(2 * (u_) + 1) * 4096 + so, (pb_) + 8192); DMA16(vgu + (size_t)(2 * (u_)) * 4096 + so, 32768 + (pb_)); DMA16(vgu + (size_t)(2 * (u_) + 1) * 4096 + so, 32768 + (pb_) + 8192); } while (0)
                    DMA_PAIR(0, 0);
                    bf16x8 qf[8];
#pragma unroll
                    for (int s = 0; s < 8; ++s) qf[s] = *(const bf16x8*)(Z + (size_t)(q0g + r) * OD_IN + hd * 128 + 16 * s + 8 * hh);
                    unsigned selmask = 0u;
                    if (own > 0) {
                        f32x16 gt;
#pragma unroll
                        for (int i = 0; i < 16; ++i) gt[i] = 0.f;
                        const long long* ks = (const long long*)KSUM + ((size_t)(b * 4 + kvh) * 16 + (r & 15)) * 128 + 8 * hh;
#pragma unroll
                        for (int s = 0; s < 8; ++s) { f32x4 a0, a1;
#pragma unroll
                            for (int e = 0; e < 4; ++e) { a0[e] = (float)ks[16 * s + e] * (1.0f / 4294967296.0f); a1[e] = (float)ks[16 * s + 4 + e] * (1.0f / 4294967296.0f); }
                            v4u hi; hi.x = cvtpk(a0[0], a0[1]); hi.y = cvtpk(a0[2], a0[3]); hi.z = cvtpk(a1[0], a1[1]); hi.w = cvtpk(a1[2], a1[3]);
                            v4u lo; lo.x = cvtpk(a0[0] - bflo(hi.x), a0[1] - bfhi(hi.x)); lo.y = cvtpk(a0[2] - bflo(hi.y), a0[3] - bfhi(hi.y)); lo.z = cvtpk(a1[0] - bflo(hi.z), a1[1] - bfhi(hi.z)); lo.w = cvtpk(a1[2] - bflo(hi.w), a1[3] - bfhi(hi.w));
                            gt = MFMA32(__builtin_bit_cast(bf16x8, hi), qf[s], gt); gt = MFMA32(__builtin_bit_cast(bf16x8, lo), qf[s], gt); }
                        float glo[8], ghi[8];
#pragma unroll
                        for (int i = 0; i < 8; ++i) { const float mine = gt[i], oth = __shfl_xor(mine, 32); glo[i] = hh ? oth : mine; ghi[i] = hh ? mine : oth; }
                        float s0 = -INFINITY, s1 = -INFINITY, s2 = -INFINITY; int i0 = -1, i1 = -1, i2 = -1;
#pragma unroll
                        for (int n = 0; n < 16; ++n) { const float g = (n & 4) ? ghi[(n & 3) + 4 * (n >> 3)] : glo[(n & 3) + 4 * (n >> 3)]; if (n < own) TOP3_INSERT(g, n); }
                        selmask = (i0 >= 0 ? 1u << i0 : 0u) | (i1 >= 0 ? 1u << i1 : 0u) | (i2 >= 0 ? 1u << i2 : 0u);
                    }
                    f32x16 o[4];
#pragma unroll
                    for (int dg = 0; dg < 4; ++dg)
#pragma unroll
                        for (int i = 0; i < 16; ++i) o[dg][i] = 0.f;
                    float m_run = -1e30f, l_run = 0.f; const int qpos = j * 32 + r;
                    __syncthreads();
                    const int umax = 2 * jg + 1;
                    auto logits = [&](int tt, f32x16& s_) {
                        const int n = tt >> 3; const bool sel = (n >= own) || ((selmask >> n) & 1u);
                        if (j * 32 - (tt * 32 + 31) >= 128) { const float madd = sel ? b128 : -INFINITY; s_ = s_ * scale2 + madd; }
                        else { const LAS float* bp = tb + (TPAD - 23) + (qpos - tt * 32 - 8 * hh); const float madd = sel ? 0.0f : -INFINITY;
#pragma unroll
                            for (int i = 0; i < 16; ++i) s_[i] = __builtin_fmaf(s_[i], scale2, bp[23 - kofs(i)] + madd); } };
#pragma unroll 1
                    for (int u = 0; u <= umax; ++u) {
                        if (u < umax) DMA_PAIR(u + 1, ((u + 1) & 1) * 16384);
                        if (2 * u <= j) {
                            const int ta = 2 * u; const bool hasb = (ta + 1 <= j);
                            const LAS bf16* kl = (const LAS bf16*)(lds + (u & 1) * 16384) + (hh * 32 + pr) * 8; const LAS bf16* vl = (const LAS bf16*)(lds + 32768 + (u & 1) * 16384) + (hh * 128 + r) * 8;
                            f32x16 st0, st1;
                            { bf16x8 kfa[8], kfb[8];
#pragma unroll
                              for (int s = 0; s < 8; ++s) { kfa[s] = *(const LAS bf16x8*)(kl + s * 512); kfb[s] = *(const LAS bf16x8*)(kl + 4096 + s * 512); }
#pragma unroll
                              for (int i = 0; i < 16; ++i) { st0[i] = 0.f; st1[i] = 0.f; }
#pragma unroll
                              for (int s = 0; s < 8; ++s) { st0 = MFMA32(kfa[s], qf[s], st0); st1 = MFMA32(kfb[s], qf[s], st1); } }
                            if (hasb) logits(ta + 1, st1);
                            else {
#pragma unroll
                              for (int i = 0; i < 16; ++i) st1[i] = -INFINITY; }
                            logits(ta, st0);
                            float tmax = fmaxf(fmaxf(st0[0], st0[1]), st0[2]);
#pragma unroll
                            for (int i = 3; i < 15; i += 2) tmax = fmaxf(fmaxf(tmax, st0[i]), st0[i + 1]);
                            tmax = fmaxf(tmax, st0[15]);
#pragma unroll
                            for (int i = 0; i < 16; i += 2) tmax = fmaxf(fmaxf(tmax, st1[i]), st1[i + 1]);
                            { auto rr_ = __builtin_amdgcn_permlane32_swap(__float_as_uint(tmax), __float_as_uint(tmax), false, false); tmax = fmaxf(__uint_as_float(rr_[0]), __uint_as_float(rr_[1])); }
                            if (__any(tmax > m_run + 8.0f)) {
                                const float mn = fmaxf(m_run, tmax), corr = __builtin_amdgcn_exp2f(m_run - mn); m_run = mn; l_run *= corr;
#pragma unroll
                                for (int dg = 0; dg < 4; ++dg) o[dg] = o[dg] * corr;
                            }
                            st0 = st0 - m_run; st1 = st1 - m_run;
#pragma unroll
                            for (int i = 0; i < 16; ++i) { st0[i] = __builtin_amdgcn_exp2f(st0[i]); st1[i] = __builtin_amdgcn_exp2f(st1[i]); }
                            { float ps = (((st0[0] + st0[1]) + (st0[2] + st0[3])) + ((st0[4] + st0[5]) + (st0[6] + st0[7]))) + (((st0[8] + st0[9]) + (st0[10] + st0[11])) + ((st0[12] + st0[13]) + (st0[14] + st0[15])));
                              ps += (((st1[0] + st1[1]) + (st1[2] + st1[3])) + ((st1[4] + st1[5]) + (st1[6] + st1[7]))) + (((st1[8] + st1[9]) + (st1[10] + st1[11])) + ((st1[12] + st1[13]) + (st1[14] + st1[15])));
                              { auto rr_ = __builtin_amdgcn_permlane32_swap(__float_as_uint(ps), __float_as_uint(ps), false, false); ps = __uint_as_float(rr_[0]) + __uint_as_float(rr_[1]); }
                              l_run += ps; }
                            { v4u p0, p1; p0.x = cvtpk(st0[0], st0[1]); p0.y = cvtpk(st0[2], st0[3]); p0.z = cvtpk(st0[4], st0[5]); p0.w = cvtpk(st0[6], st0[7]);
                              p1.x = cvtpk(st0[8], st0[9]); p1.y = cvtpk(st0[10], st0[11]); p1.z = cvtpk(st0[12], st0[13]); p1.w = cvtpk(st0[14], st0[15]);
                              const bf16x8 pf0 = __builtin_bit_cast(bf16x8, p0), pf1 = __builtin_bit_cast(bf16x8, p1);
#pragma unroll
                              for (int dg = 0; dg < 4; ++dg) { o[dg] = MFMA32(*(const LAS bf16x8*)(vl + dg * 256), pf0, o[dg]); o[dg] = MFMA32(*(const LAS bf16x8*)(vl + 2048 + dg * 256), pf1, o[dg]); } }
                            { v4u p0, p1; p0.x = cvtpk(st1[0], st1[1]); p0.y = cvtpk(st1[2], st1[3]); p0.z = cvtpk(st1[4], st1[5]); p0.w = cvtpk(st1[6], st1[7]);
                              p1.x = cvtpk(st1[8], st1[9]); p1.y = cvtpk(st1[10], st1[11]); p1.z = cvtpk(st1[12], st1[13]); p1.w = cvtpk(st1[14], st1[15]);
                              const bf16x8 pf0 = __builtin_bit_cast(bf16x8, p0), pf1 = __builtin_bit_cast(bf16x8, p1);
#pragma unroll
                              for (int dg = 0; dg < 4; ++dg) { o[dg] = MFMA32(*(const LAS bf16x8*)(vl + 4096 + dg * 256), pf0, o[dg]); o[dg] = MFMA32(*(const LAS bf16x8*)(vl + 4096 + 2048 + dg * 256), pf1, o[dg]); } }
                        }
                        __syncthreads();
                    }
#undef DMA_PAIR
#undef DMA16
                    attn_store<128>(Y + (size_t)(q0g + r) * D + hd * 128, o, l_run, hh); }
            }
        }
        GSYNC();
        for (int rep = 0; rep < NREP(5); ++rep) { const bool fin = rep == NREP(5) - 1; pg8::Gemm g{Y, W + (l == 0 ? WO_EVOUT : WO_ODOUT), T, D, D}; pg8::StaticOrder S; S.init(T, D, G, bx);
          pg8::EpiResid E{nullptr, XB, fin ? ssl + 2 * TS16 : SS + 9 * TS16, fin ? 1.0f : 0.0f};
          pg8::gemm_phase<pg8::EpiResid, pg8::StaticOrder, true, true>(lds, g, S, E); }
        GSYNC();
        for (int rep = 0; rep < NREP(6); ++rep) { pg8::Gemm g{XB, W + WO_XQ + (size_t)l * XAW * D, T, XAW, D}; pg8::StaticOrder S; S.init(T, XAW, G, bx);
          pg8::EpiScaleBf16 E{XQ, XAW, ssl + 2 * TS16};
          pg8::gemm_phase<pg8::EpiScaleBf16, pg8::StaticOrder, true, true>(lds, g, S, E); }
        GSYNC();
        { const int hd = wave & 3; const float scale2 = 0.08838834764831845f * LOG2E;
          for (int rep = 0; rep < NREP(7); ++rep) for (int w = bx; w < T / 128; w += G)
            for (int jj = 0; jj < 2; ++jj) { const int qt = w * 4 + (wave >> 2) * 2 + jj, b = qt >> 7, q0g = qt * 32;
                bf16x8 qf[8];
#pragma unroll
                for (int s = 0; s < 8; ++s) qf[s] = *(const bf16x8*)(XQ + (size_t)(q0g + r) * XAW + hd * 128 + 16 * s + 8 * hh);
                f32x16 o[4];
#pragma unroll
                for (int dg = 0; dg < 4; ++dg)
#pragma unroll
                    for (int i = 0; i < 16; ++i) o[dg][i] = 0.f;
                float m_run = -1e30f, l_run = 0.f;
                const size_t tb0 = ((size_t)l * 32 + b * 4 + hd) * 8 * 4096;
                attn_run<128>(XKP + tb0 + (hh * 32 + pr) * 8, XVP + tb0 + (hh * 128 + r) * 8, 0, 7, qf, o, m_run, l_run, [&](int t, f32x16& st) {
#pragma unroll
                    for (int i = 0; i < 16; ++i) st[i] *= scale2; });
                attn_store<128>(XO + (size_t)(q0g + r) * XAW + hd * 128, o, l_run, hh); } }
        GSYNC();
        for (int rep = 0; rep < NREP(8); ++rep) { const bool fin = rep == NREP(8) - 1; pg8::Gemm g{XO, W + WO_XO + (size_t)l * D * XAW, T, D, XAW}; pg8::StaticOrder S; S.init(T, D, G, bx);
          pg8::EpiResid E{nullptr, XB, fin ? ssl + 3 * TS16 : SS + 9 * TS16, fin ? 1.0f : 0.0f};
          pg8::gemm_phase<pg8::EpiResid, pg8::StaticOrder, true, true>(lds, g, S, E); }
        GSYNC();
        for (int rep = 0; rep < NREP(0); ++rep) { pg8::Gemm g{XB, W + WO_GU2 + l * W_GU, T, 2 * FF, D}; pg8::StaticOrder S; S.init(T, 2 * FF, G, bx);
          pg8::EpiSwiglu E{R1, FF, ssl + 3 * TS16};
          pg8::gemm_phase<pg8::EpiSwiglu, pg8::StaticOrder, true, true>(lds, g, S, E); }
        GSYNC();
        for (int rep = 0; rep < NREP(1); ++rep) { const bool fin = rep == NREP(1) - 1; pg8::Gemm g{R1, W + WO_DN2 + l * W_DN, T, D, FF}; pg8::StaticOrder S; S.init(T, D, G, bx);
          pg8::EpiResid E{nullptr, XB, fin ? ssl + 4 * TS16 : SS + 9 * TS16, fin ? 0.5f : 0.0f};
          pg8::gemm_phase<pg8::EpiResid, pg8::StaticOrder, true, true>(lds, g, S, E); }
        GSYNC();
}

__global__ void __launch_bounds__(NWAVES * 64, 2) mk_fwd(Args args) {
    extern __shared__ __attribute__((aligned(16))) unsigned char lds_raw[];
    cg::grid_group grid = cg::this_grid();
    LAS unsigned char* lds = (LAS unsigned char*)lds_raw;
    const int tid = threadIdx.x, lane = tid & 63, wave = __builtin_amdgcn_readfirstlane(tid >> 6);
    const int G = gridDim.x, bx = blockIdx.x;
    const int gw = bx * NWAVES + wave, NGW = G * NWAVES;
    unsigned char* ws = args.ws;
    float* KSUM = (float*)(ws + WS_KSUM); float* SS = (float*)(ws + WS_SS);
    bf16* W = (bf16*)(ws + WS_W); bf16* MEMN = (bf16*)(ws + WS_MEMN); bf16* XKP = (bf16*)(ws + WS_XKP); bf16* XVP = (bf16*)(ws + WS_XVP);
    bf16* XB = (bf16*)(ws + WS_XB);
    const float* x_in = args.in[0]; float* OUT = args.out;
    if (tid < 2) ((LAS unsigned*)(lds + LDS_BARST_OFF))[tid] = 0u;
    __syncthreads();
    const XcdBarrier bar = xcd_barrier_post((unsigned*)(ws + WS_BAR), (volatile LAS unsigned*)(lds + LDS_BARST_OFF));

    for (int prep = 0; prep < NREP(10); ++prep) {
        LAS float* scr = (LAS float*)(lds + wave * 16384);
        for (int it = gw; it < N_JOB_ITEMS; it += NGW) {
            int r = it, j = 0; Job jb;
            for (;;) { jb = get_job(j, args, W); const int cnt = (jb.K / 64) * (jb.N / 32); if (r < cnt || j >= 21) break; r -= cnt; ++j; }
            transpose_item(jb, scr, r, lane);
        }
        for (int m0 = gw; m0 < T; m0 += 4 * NGW) {
            f32x4 v[4][4];
#pragma unroll
            for (int k = 0; k < 4; ++k) { const int m = m0 + k * NGW; if (m < T) { const f32x4* xr = (const f32x4*)(x_in + (size_t)m * D) + lane;
#pragma unroll
                for (int j = 0; j < 4; ++j) v[k][j] = xr[64 * j]; } }
#pragma unroll
            for (int k = 0; k < 4; ++k) { const int m = m0 + k * NGW; if (m < T) { float s = 0.f;
#pragma unroll
                for (int j = 0; j < 4; ++j) s += (v[k][j].x * v[k][j].x + v[k][j].y * v[k][j].y) + (v[k][j].z * v[k][j].z + v[k][j].w * v[k][j].w);
                s = wave_sum(s);
                v2u* o8 = (v2u*)(XB + (size_t)m * D) + lane;
#pragma unroll
                for (int j = 0; j < 4; ++j) { v2u o; o.x = pk2(v[k][j].x, v[k][j].y); o.y = pk2(v[k][j].z, v[k][j].w); o8[64 * j] = o; }
                if (lane == 0) ((unsigned long long*)SS)[m] = (unsigned long long)(s * 4294967296.0f); } }
        }
        for (int m = gw; m < MEMROWS; m += NGW) {
            const f32x4* xr = (const f32x4*)(args.in[1] + (size_t)m * D) + lane; const f32x4* gr = (const f32x4*)(args.in[18]) + lane; float s = 0.f; f32x4 v[4];
#pragma unroll
            for (int j = 0; j < 4; ++j) { v[j] = xr[64 * j]; s += (v[j].x * v[j].x + v[j].y * v[j].y) + (v[j].z * v[j].z + v[j].w * v[j].w); }
            s = wave_sum(s); const float rs = 1.0f / sqrtf(s * (1.0f / D) + 1e-6f);
            v2u* o8 = (v2u*)(MEMN + (size_t)m * D) + lane;
#pragma unroll
            for (int j = 0; j < 4; ++j) { const f32x4 g = gr[64 * j]; v2u o; o.x = pk2(v[j].x * rs * g.x, v[j].y * rs * g.y); o.y = pk2(v[j].z * rs * g.z, v[j].w * rs * g.w); o8[64 * j] = o; }
        }
        for (int i = bx * 512 + tid; i < 9 * T; i += G * 512) ((unsigned long long*)SS)[T + i] = 0ull;
        for (int i = bx * 512 + tid; i < NBATCH * 4 * 16 * 128; i += G * 512) ((unsigned long long*)KSUM)[i] = 0ull;
        build_bias_table(lds, args.in[13], true);
    }
    if (args.ws == nullptr) grid.sync();
    xcd_barrier(bar);

    layer_body<0>(args, lds, bar);
    layer_body<1>(args, lds, bar);
    int tidf_ = threadIdx.x; asm volatile("" : "+v"(tidf_)); const int lanef = tidf_ & 63, gwf = bx * NWAVES + __builtin_amdgcn_readfirstlane(tidf_ >> 6);
    for (int m0 = gwf; m0 < T; m0 += 4 * NGW) {
        const f32x4* gr = (const f32x4*)(args.in[23]) + lanef; v2u w[4][4];
#pragma unroll
        for (int k = 0; k < 4; ++k) { const int m = m0 + k * NGW; if (m < T) { const v2u* xr = (const v2u*)(XB + (size_t)m * D) + lanef;
#pragma unroll
            for (int j = 0; j < 4; ++j) w[k][j] = xr[64 * j]; } }
#pragma unroll
        for (int k = 0; k < 4; ++k) { const int m = m0 + k * NGW; if (m < T) { f32x4* orow = (f32x4*)(OUT + (size_t)m * D) + lanef; float s = 0.f; f32x4 v[4];
#pragma unroll
            for (int j = 0; j < 4; ++j) { v[j] = (f32x4){bflo(w[k][j].x), bfhi(w[k][j].x), bflo(w[k][j].y), bfhi(w[k][j].y)}; s += (v[j].x * v[j].x + v[j].y * v[j].y) + (v[j].z * v[j].z + v[j].w * v[j].w); }
            s = wave_sum(s); const float rs = 1.0f / sqrtf(s * (1.0f / D) + 1e-6f);
#pragma unroll
            for (int j = 0; j < 4; ++j) { const f32x4 g = gr[64 * j]; orow[64 * j] = (f32x4){v[j].x * rs * g.x, v[j].y * rs * g.y, v[j].z * rs * g.z, v[j].w * rs * g.w}; } } }
    }
}

extern "C" void kernel_launch(void* const* d_in, const int* in_sizes, int n_in, void* d_out, int out_size, void* d_ws, size_t ws_size, hipStream_t stream) {
    static int grid = 0;
    if (grid == 0) {
        if (n_in != 24 || in_sizes[0] != T * D || out_size != T * D || ws_size < WS_END) { fprintf(stderr, "kernel_launch: unexpected shapes (n_in %d, in0 %d, out %d, ws %zu)\n", n_in, n_in > 0 ? in_sizes[0] : -1, out_size, ws_size); grid = -1; return; }
        int dev = 0, cus = 0, per_cu = 0;
        (void)hipGetDevice(&dev); (void)hipDeviceGetAttribute(&cus, hipDeviceAttributeMultiprocessorCount, dev);
        if (hipFuncSetAttribute((const void*)mk_fwd, hipFuncAttributeMaxDynamicSharedMemorySize, LDS_BYTES) != hipSuccess) { fprintf(stderr, "kernel_launch: hipFuncSetAttribute failed\n"); grid = -1; return; }
        if (hipOccupancyMaxActiveBlocksPerMultiprocessor(&per_cu, (const void*)mk_fwd, NWAVES * 64, LDS_BYTES) != hipSuccess || per_cu < 1) { fprintf(stderr, "kernel_launch: occupancy query says %d\n", per_cu); per_cu = 1; }
        (void)hipGetLastError();
        grid = cus;
        if (grid <= 0) grid = 256;
    }
    if (grid < 0) return;
    if (hipMemsetAsync((char*)d_ws + WS_BAR, 0, XCD_BAR_WORDS * 4, stream) != hipSuccess) { fprintf(stderr, "kernel_launch: memset failed\n"); return; }
    Args a{};
    for (int i = 0; i < 24; ++i) a.in[i] = (const float*)d_in[i];
    a.out = (float*)d_out; a.ws = (unsigned char*)d_ws;
    void* kargs[] = {&a};
    hipError_t e = hipLaunchCooperativeKernel((const void*)mk_fwd, dim3(grid), dim3(NWAVES * 64), kargs, LDS_BYTES, stream);
    if (e != hipSuccess) fprintf(stderr, "kernel_launch: cooperative launch failed: %s (grid %d)\n", hipGetErrorString(e), grid);
}
```

```cpp
#include <hip/hip_runtime.h>
#include <hip/hip_cooperative_groups.h>
#include <cstdio>
#include <cstdint>
namespace cg = cooperative_groups;
namespace pg8 {
#define PG8_LAS __attribute__((address_space(3)))
typedef unsigned short bf16_t;
typedef short bf16x8 __attribute__((ext_vector_type(8)));
typedef float f32x4 __attribute__((ext_vector_type(4)));
typedef unsigned u32x4 __attribute__((ext_vector_type(4)));
constexpr int BM = 256, BK = 64, HALF = 128, HTB = HALF * BK * 2  , STAGE_BYTES = 8 * HTB, NXCD = 8, WGM = 8;

__host__ __device__ __forceinline__ int lds_byte(int r, int c) { const int st = (r >> 4) * 2 + (c >> 5), rr = r & 15, cc = c & 31, ob = rr * 64 + cc * 2; return st * 1024 + (ob ^ (((ob >> 9) & 1) << 5)); }
__host__ __device__ __forceinline__ void stage_rc(int b, int& R, int& C) { const int st = b / 1024, sb = b % 1024, swz = sb ^ (((sb >> 9) & 1) << 5); R = (st >> 1) * 16 + swz / 64; C = (st & 1) * 32 + (swz % 64) / 2; }
__host__ __device__ __forceinline__ int perm32(int rho) { const int n = rho >> 4, i = rho & 15; return 8 * (i >> 2) + 4 * n + (i & 3); }

struct Unit { int pm, pn; };
struct Gemm { const bf16_t* A; const bf16_t* Bt; int M, N, K; };

struct StaticOrder {
    int nM, nN, nwg, G, c;
    __host__ __device__ void init(int M, int N, int G_, int c_) { nM = M / BM; nN = N / BM; nwg = nM * nN; G = G_; c = c_; }
    __host__ __device__ bool next(int i, Unit& u) const {
        const long L = (long)i * G + c; if (L >= nwg) return false;
        int wgid = (int)L; { const int q = nwg / NXCD, r = nwg % NXCD, xcd = wgid % NXCD, off = wgid / NXCD; wgid = (xcd < r ? xcd * (q + 1) : r * (q + 1) + (xcd - r) * q) + off; }
        const int nig = WGM * nN, gid = wgid / nig, fm = gid * WGM, gsz = (nM - fm) < WGM ? (nM - fm) : WGM;
        u.pm = fm + ((wgid % nig) % gsz); u.pn = (wgid % nig) / gsz; return true;
    }
    __device__ __forceinline__ void a_ready(const Unit&) const {}
    __device__ __forceinline__ void done(const Unit&) const {}
};

__device__ __forceinline__ unsigned cvt_pk_bf16(float lo, float hi) { unsigned r; asm volatile("v_cvt_pk_bf16_f32 %0, %1, %2" : "=v"(r) : "v"(lo), "v"(hi)); return r; }
constexpr float RMS_EPS = 1e-6f;
__device__ __forceinline__ float row_rs(const float* ssp, int row) { const unsigned long long v = ((const unsigned long long*)ssp)[row];
    return __builtin_amdgcn_rsqf((float)v * (1.0f / 4294967296.0f) * (1.0f / 1024.0f) + RMS_EPS); }
__device__ __forceinline__ void fx_add(float* p, size_t idx, float s) { atomicAdd((unsigned long long*)p + idx, (unsigned long long)(long long)(s * 4294967296.0f)); }
typedef float f32x2v_ __attribute__((ext_vector_type(2))); typedef __bf16 bf16x2v_ __attribute__((ext_vector_type(2)));
__device__ __forceinline__ unsigned cvtpk(float lo, float hi) { f32x2v_ v = {lo, hi}; bf16x2v_ b = __builtin_convertvector(v, bf16x2v_); return __builtin_bit_cast(unsigned, b); }
struct EpiSwiglu {
    static constexpr bool PERM = true, AFTER_DRAIN = false;
    bf16_t* H; int ldh; const float* ss;
    __device__ __forceinline__ void operator()(const f32x4 (&acc)[2][2][4][2], const Unit& u, int wr, int wc, int fr, int fq) const {
        const int row0 = u.pm * BM + wr * 64 + fr, col0 = u.pn * HALF + wc * 32 + 8 * fq;
#pragma unroll
        for (int ai = 0; ai < 2; ++ai)
#pragma unroll
            for (int m = 0; m < 4; ++m) { const int row = row0 + ai * HALF + m * 16; const float rs = row_rs(ss, row);
                float hv[8];
#pragma unroll
                for (int n = 0; n < 2; ++n)
#pragma unroll
                    for (int i = 0; i < 4; ++i) { const float g = acc[ai][0][m][n][i] * rs, uu = acc[ai][1][m][n][i] * rs;
                        hv[n * 4 + i] = g * __builtin_amdgcn_rcpf(1.0f + __expf(-g)) * uu; }
                u32x4 w; w.x = cvtpk(hv[0], hv[1]); w.y = cvtpk(hv[2], hv[3]); w.z = cvtpk(hv[4], hv[5]); w.w = cvtpk(hv[6], hv[7]);
                *(u32x4*)(H + (size_t)row * ldh + col0) = w; }
    }
};
struct EpiScaleBf16 {
    static constexpr bool PERM = true, AFTER_DRAIN = false;
    bf16_t* O; int ldc; const float* ss;
    __device__ __forceinline__ void operator()(const f32x4 (&acc)[2][2][4][2], const Unit& u, int wr, int wc, int fr, int fq) const {
        const int row0 = u.pm * BM + wr * 64 + fr, col0 = u.pn * BM + wc * 32 + 8 * fq;
#pragma unroll
        for (int ai = 0; ai < 2; ++ai)
#pragma unroll
            for (int m = 0; m < 4; ++m) { const int row = row0 + ai * HALF + m * 16; const float rs = ss ? row_rs(ss, row) : 1.0f;
#pragma unroll
                for (int bj = 0; bj < 2; ++bj) { const f32x4 v0 = acc[ai][bj][m][0] * rs, v1 = acc[ai][bj][m][1] * rs;
                    u32x4 w; w.x = cvtpk(v0[0], v0[1]); w.y = cvtpk(v0[2], v0[3]); w.z = cvtpk(v1[0], v1[1]); w.w = cvtpk(v1[2], v1[3]);
                    *(u32x4*)(O + (size_t)row * ldc + col0 + bj * HALF) = w; } }
    }
};
struct EpiResid {
    static constexpr bool PERM = true, AFTER_DRAIN = false;
    const float* xin32; bf16_t* xb; float* ssout; float alpha;
    __device__ __forceinline__ void operator()(const f32x4 (&acc)[2][2][4][2], const Unit& u, int wr, int wc, int fr, int fq) const {
        const int row0 = u.pm * BM + wr * 64 + fr, col0 = u.pn * BM + wc * 32 + 8 * fq;
#pragma unroll
        for (int ai = 0; ai < 2; ++ai)
#pragma unroll
            for (int m = 0; m < 4; ++m) { const int row = row0 + ai * HALF + m * 16; const size_t off = (size_t)row * 1024 + col0; float s = 0.f;
#pragma unroll
                for (int bj = 0; bj < 2; ++bj) { f32x4 a0, a1;
                    if (xin32) { const float* p = xin32 + off + bj * HALF; a0 = *(const f32x4*)p; a1 = *(const f32x4*)(p + 4); }
                    else { const u32x4 w = *(const u32x4*)(xb + off + bj * HALF);
                        a0 = (f32x4){__uint_as_float(w.x << 16), __uint_as_float(w.x & 0xffff0000u), __uint_as_float(w.y << 16), __uint_as_float(w.y & 0xffff0000u)};
                        a1 = (f32x4){__uint_as_float(w.z << 16), __uint_as_float(w.z & 0xffff0000u), __uint_as_float(w.w << 16), __uint_as_float(w.w & 0xffff0000u)}; }
                    const f32x4 v0 = a0 + acc[ai][bj][m][0] * alpha, v1 = a1 + acc[ai][bj][m][1] * alpha;
                    u32x4 w; w.x = cvtpk(v0[0], v0[1]); w.y = cvtpk(v0[2], v0[3]); w.z = cvtpk(v1[0], v1[1]); w.w = cvtpk(v1[2], v1[3]);
                    *(u32x4*)(xb + off + bj * HALF) = w;
                    s += (v0[0] * v0[0] + v0[1] * v0[1]) + (v0[2] * v0[2] + v0[3] * v0[3]) + (v1[0] * v1[0] + v1[1] * v1[1]) + (v1[2] * v1[2] + v1[3] * v1[3]); }
                s += __shfl_xor(s, 16); s += __shfl_xor(s, 32);
                if (fq == 0) fx_add(ssout, row, s); }
    }
};
struct EpiQKV {
    static constexpr bool PERM = true, AFTER_DRAIN = false;
    bf16_t* O; int ldc; const float* ss; bf16_t* KP; bf16_t* VP; int kbeg, vbeg, dh_shift, kvh, S_shift; float* ksum;
    __device__ __forceinline__ void operator()(const f32x4 (&acc)[2][2][4][2], const Unit& u, int wr, int wc, int fr, int fq) const {
        const int row0 = u.pm * BM + wr * 64 + fr; const int DH = 1 << dh_shift;
#pragma unroll
        for (int bj = 0; bj < 2; ++bj) {
            const int cbase = u.pn * BM + bj * HALF, c0 = cbase + wc * 32 + 8 * fq;
            if (cbase < kbeg) {
#pragma unroll
                for (int ai = 0; ai < 2; ++ai)
#pragma unroll
                    for (int m = 0; m < 4; ++m) { const int row = row0 + ai * HALF + m * 16; const float rs = ss ? row_rs(ss, row) : 1.0f;
                        const f32x4 v0 = acc[ai][bj][m][0] * rs, v1 = acc[ai][bj][m][1] * rs;
                        u32x4 w; w.x = cvtpk(v0[0], v0[1]); w.y = cvtpk(v0[2], v0[3]); w.z = cvtpk(v1[0], v1[1]); w.w = cvtpk(v1[2], v1[3]);
                        *(u32x4*)(O + (size_t)row * ldc + c0) = w; }
            } else if (cbase < vbeg) {
                const int c = c0 - kbeg, head = c >> dh_shift, d = c & (DH - 1);
                float cs[8];
#pragma unroll
                for (int e = 0; e < 8; ++e) cs[e] = 0.f;
#pragma unroll
                for (int ai = 0; ai < 2; ++ai)
#pragma unroll
                    for (int m = 0; m < 4; ++m) { const int row = row0 + ai * HALF + m * 16; const float rs = ss ? row_rs(ss, row) : 1.0f;
                        const f32x4 v0 = acc[ai][bj][m][0] * rs, v1 = acc[ai][bj][m][1] * rs;
                        const int b = row >> S_shift, pos = row & ((1 << S_shift) - 1);
                        const size_t tile = ((size_t)(b * kvh + head) << (S_shift - 5)) + (pos >> 5);
                        u32x4 w; w.x = cvtpk(v0[0], v0[1]); w.y = cvtpk(v0[2], v0[3]); w.z = cvtpk(v1[0], v1[1]); w.w = cvtpk(v1[2], v1[3]);
                        *(u32x4*)(KP + tile * (size_t)(32 * DH) + ((d >> 3) * 32 + (pos & 31)) * 8) = w;
#pragma unroll
                        for (int e = 0; e < 4; ++e) { cs[e] += v0[e]; cs[4 + e] += v1[e]; } }
                if (ksum) {
#pragma unroll
                    for (int e = 0; e < 8; ++e) { float s = cs[e]; s += __shfl_xor(s, 1); s += __shfl_xor(s, 2); s += __shfl_xor(s, 4); s += __shfl_xor(s, 8); cs[e] = s; }
                    if (fr == 0) { const int rowb = u.pm * BM; const int b = rowb >> S_shift, blk = (rowb & ((1 << S_shift) - 1)) >> 8;
                        const size_t kd = ((size_t)((b * kvh + head) << (S_shift - 8)) + blk) * DH + d;
#pragma unroll
                        for (int e = 0; e < 8; ++e) fx_add(ksum, kd + e, cs[e]); }
                }
            } else {
                const int c = c0 - vbeg, head = c >> dh_shift, d = c & (DH - 1);
#pragma unroll
                for (int ai = 0; ai < 2; ++ai)
#pragma unroll
                    for (int m = 0; m < 4; ++m) { const int row = row0 + ai * HALF + m * 16; const float rs = ss ? row_rs(ss, row) : 1.0f;
                        const f32x4 v0 = acc[ai][bj][m][0] * rs, v1 = acc[ai][bj][m][1] * rs;
                        const int b = row >> S_shift, pos = row & ((1 << S_shift) - 1);
                        const size_t tile = ((size_t)(b * kvh + head) << (S_shift - 5)) + (pos >> 5);
                        bf16_t* vp = VP + tile * (size_t)(32 * DH) + ((((pos & 31) >> 3) << dh_shift) + d) * 8 + (pos & 7);
                        const unsigned w0 = cvtpk(v0[0], v0[1]), w1 = cvtpk(v0[2], v0[3]), w2 = cvtpk(v1[0], v1[1]), w3 = cvtpk(v1[2], v1[3]);
                        vp[0] = (bf16_t)(w0 & 0xffffu); vp[8] = (bf16_t)(w0 >> 16); vp[16] = (bf16_t)(w1 & 0xffffu); vp[24] = (bf16_t)(w1 >> 16);
                        vp[32] = (bf16_t)(w2 & 0xffffu); vp[40] = (bf16_t)(w2 >> 16); vp[48] = (bf16_t)(w3 & 0xffffu); vp[56] = (bf16_t)(w3 >> 16); }
            }
        }
    }
};
template <class Epi, class Sched, bool ALIGN_EPI = false, bool SP2 = false>
__device__ __forceinline__ void gemm_phase(PG8_LAS unsigned char* lds, const Gemm g, const Sched& S, const Epi& E) {
    int tid_ = threadIdx.x; asm volatile("" : "+v"(tid_));
    const int tid = tid_, wid = __builtin_amdgcn_readfirstlane(tid >> 6), lane = tid & 63, wr = wid >> 2, wc = wid & 3, fr = lane & 15, fq = lane >> 4;
    const int K = g.K, nt = K / BK;
    unsigned voffA[2], voffB[2];
#pragma unroll
    for (int i = 0; i < 2; ++i) { int R, C; stage_rc(tid * 16 + i * 8192, R, C); const int Rb = Epi::PERM ? ((R & ~31) + perm32(R & 31)) : R;
        voffA[i] = (unsigned)(R * K + C) * 2u; voffB[i] = (unsigned)(Rb * K + C) * 2u; }
    const size_t kstep = (size_t)(BK * 2);
    const size_t hstep = (size_t)HALF * K * 2;
    const size_t tstep = 2 * hstep;
    const unsigned ldsw = (unsigned)wid * 1024u;
    const int aoff = lds_byte(wr * 64 + fr, fq * 8), boff = lds_byte(wc * 32 + fr, fq * 8);
#define PG8_SA(b, h) (((b) * 2 + (h)) * HTB)
#define PG8_SB(b, h) ((4 + (b) * 2 + (h)) * HTB)
#define PG8_STAGE(bufoff, gbase, voff) do { _Pragma("unroll") for (int _i = 0; _i < 2; ++_i) \
        __builtin_amdgcn_global_load_lds((const unsigned*)((const char*)(gbase) + (voff)[_i]), (PG8_LAS unsigned*)(lds + (bufoff) + ldsw + _i * 8192), 16, 0, 0); } while (0)
#define PG8_LDA(dst, b, h) do { _Pragma("unroll") for (int m = 0; m < 4; ++m) _Pragma("unroll") for (int k = 0; k < 2; ++k) dst[m][k] = *(const PG8_LAS bf16x8*)(lds + PG8_SA(b, h) + aoff + m * 2048 + k * 1024); } while (0)
#define PG8_LDB(dst, b, h) do { _Pragma("unroll") for (int n = 0; n < 2; ++n) _Pragma("unroll") for (int k = 0; k < 2; ++k) dst[n][k] = *(const PG8_LAS bf16x8*)(lds + PG8_SB(b, h) + boff + n * 2048 + k * 1024); } while (0)
#define PG8_MMA(ai, bj, At, Bt) do { __builtin_amdgcn_s_setprio(1); _Pragma("unroll") for (int m = 0; m < 4; ++m) _Pragma("unroll") for (int n = 0; n < 2; ++n) _Pragma("unroll") for (int k = 0; k < 2; ++k) \
        acc[ai][bj][m][n] = __builtin_amdgcn_mfma_f32_16x16x32_bf16(Bt[n][k], At[m][k], acc[ai][bj][m][n], 0, 0, 0); __builtin_amdgcn_s_setprio(0); } while (0)
#define PG8_WAIT_V(n) asm volatile("s_waitcnt vmcnt(" #n ")" ::: "memory")
#define PG8_WAIT_L(n) asm volatile("s_waitcnt lgkmcnt(" #n ")" ::: "memory")
#define PG8_BAR __builtin_amdgcn_s_barrier()
#define PG8_SCHED __builtin_amdgcn_sched_barrier(0)
    Unit cur, nxt; int ui = 0;
    if (!S.next(0, cur)) return;
    f32x4 acc[2][2][4][2];
#pragma unroll
    for (int a = 0; a < 2; ++a)
#pragma unroll
        for (int b = 0; b < 2; ++b)
#pragma unroll
            for (int m = 0; m < 4; ++m)
#pragma unroll
                for (int n = 0; n < 2; ++n) acc[a][b][m][n] = (f32x4){0.f, 0.f, 0.f, 0.f};
    bf16x8 At[4][2], B0[2][2], B1[2][2];
    const char* cA = (const char*)g.A + (size_t)cur.pm * tstep; const char* cB = (const char*)g.Bt + (size_t)cur.pn * tstep;
    S.a_ready(cur);
    if constexpr (SP2) {
        PG8_STAGE(PG8_SB(0, 0), cB, voffB); PG8_STAGE(PG8_SB(0, 1), cB + hstep, voffB); PG8_STAGE(PG8_SA(0, 0), cA, voffA); PG8_STAGE(PG8_SA(0, 1), cA + hstep, voffA);
        if (wr == 1) PG8_BAR;
        PG8_WAIT_V(2); PG8_BAR;
        PG8_STAGE(PG8_SB(1, 0), cB + kstep, voffB); PG8_STAGE(PG8_SA(1, 0), cA + kstep, voffA); PG8_STAGE(PG8_SB(1, 1), cB + hstep + kstep, voffB);
        PG8_WAIT_V(6); PG8_BAR;
    } else {
        PG8_STAGE(PG8_SB(0, 0), cB, voffB); PG8_STAGE(PG8_SA(0, 0), cA, voffA); PG8_STAGE(PG8_SB(0, 1), cB + hstep, voffB); PG8_STAGE(PG8_SA(0, 1), cA + hstep, voffA);
        if (wr == 1) PG8_BAR;
        PG8_WAIT_V(4); PG8_BAR;
        PG8_STAGE(PG8_SB(1, 0), cB + kstep, voffB); PG8_STAGE(PG8_SA(1, 0), cA + kstep, voffA); PG8_STAGE(PG8_SB(1, 1), cB + hstep + kstep, voffB);
        PG8_WAIT_V(6); PG8_BAR;
    }
    for (;;) {
        const bool has_next = S.next(ui + 1, nxt);
        const char* nA = has_next ? (const char*)g.A + (size_t)nxt.pm * tstep : cA; const char* nB = has_next ? (const char*)g.Bt + (size_t)nxt.pn * tstep : cB;
        for (int t = 0; t < nt; t += 2) {
            const bool last = (t == nt - 2);
            const char* a1 = cA + (size_t)(t + 1) * kstep;
            const char* a2 = last ? nA : cA + (size_t)(t + 2) * kstep; const char* b2 = last ? nB : cB + (size_t)(t + 2) * kstep;
            const char* a3 = a2 + kstep; const char* b3 = b2 + kstep;
            if (last && has_next) S.a_ready(nxt);
            if constexpr (SP2) {
            PG8_LDB(B0, 0, 0); PG8_LDB(B1, 0, 1); PG8_SCHED; PG8_LDA(At, 0, 0); PG8_STAGE(PG8_SA(1, 1), a1 + hstep, voffA);
            PG8_WAIT_V(8); PG8_WAIT_L(0); PG8_BAR; PG8_MMA(0, 0, At, B0); PG8_MMA(0, 1, At, B1); PG8_BAR; PG8_SCHED;
            PG8_LDA(At, 0, 1); PG8_STAGE(PG8_SB(0, 0), b2, voffB); PG8_STAGE(PG8_SB(0, 1), b2 + hstep, voffB); PG8_STAGE(PG8_SA(0, 0), a2, voffA);
            PG8_WAIT_V(8); PG8_WAIT_L(0); PG8_BAR; PG8_MMA(1, 0, At, B0); PG8_MMA(1, 1, At, B1); PG8_BAR; PG8_SCHED;
            PG8_LDB(B0, 1, 0); PG8_LDB(B1, 1, 1); PG8_SCHED; PG8_LDA(At, 1, 0); PG8_STAGE(PG8_SA(0, 1), a2 + hstep, voffA);
            PG8_WAIT_V(8); PG8_WAIT_L(0); PG8_BAR; PG8_MMA(0, 0, At, B0); PG8_MMA(0, 1, At, B1); PG8_BAR; PG8_SCHED;
            PG8_LDA(At, 1, 1); PG8_STAGE(PG8_SB(1, 0), b3, voffB); PG8_STAGE(PG8_SB(1, 1), b3 + hstep, voffB); PG8_STAGE(PG8_SA(1, 0), a3, voffA);
            PG8_WAIT_V(8); PG8_WAIT_L(0); PG8_BAR; PG8_MMA(1, 0, At, B0); PG8_MMA(1, 1, At, B1); PG8_BAR; PG8_SCHED;
            } else {
            PG8_LDB(B0, 0, 0); PG8_SCHED; PG8_LDA(At, 0, 0); PG8_STAGE(PG8_SA(1, 1), a1 + hstep, voffA);
            PG8_WAIT_L(8); PG8_BAR; PG8_WAIT_L(0); PG8_MMA(0, 0, At, B0); PG8_BAR; PG8_SCHED;
            PG8_LDB(B1, 0, 1); PG8_STAGE(PG8_SB(0, 0), b2, voffB);
            PG8_BAR; PG8_WAIT_L(0); PG8_MMA(0, 1, At, B1); PG8_BAR;
            PG8_LDA(At, 0, 1); PG8_STAGE(PG8_SA(0, 0), a2, voffA);
            PG8_BAR; PG8_WAIT_L(0); PG8_MMA(1, 0, At, B0); PG8_BAR; PG8_SCHED;
            PG8_STAGE(PG8_SB(0, 1), b2 + hstep, voffB);
            PG8_WAIT_V(6); PG8_BAR; PG8_MMA(1, 1, At, B1); PG8_BAR;
            PG8_LDB(B0, 1, 0); PG8_SCHED; PG8_LDA(At, 1, 0); PG8_STAGE(PG8_SA(0, 1), a2 + hstep, voffA);
            PG8_WAIT_L(8); PG8_BAR; PG8_WAIT_L(0); PG8_MMA(0, 0, At, B0); PG8_BAR; PG8_SCHED;
            PG8_LDB(B1, 1, 1); PG8_STAGE(PG8_SB(1, 0), b3, voffB);
            PG8_BAR; PG8_WAIT_L(0); PG8_MMA(0, 1, At, B1); PG8_BAR;
            PG8_LDA(At, 1, 1); PG8_STAGE(PG8_SA(1, 0), a3, voffA);
            PG8_BAR; PG8_WAIT_L(0); PG8_MMA(1, 0, At, B0); PG8_BAR; PG8_SCHED;
            PG8_STAGE(PG8_SB(1, 1), b3 + hstep, voffB);
            PG8_WAIT_V(6); PG8_BAR; PG8_MMA(1, 1, At, B1); PG8_BAR;
            }
        }
        if constexpr (ALIGN_EPI) { if (wr == 0) PG8_BAR; }
        if constexpr (!Epi::AFTER_DRAIN) { E(acc, cur, wr, wc, fr, fq); S.done(cur); }
        if (!has_next) break;
#pragma unroll
        for (int a = 0; a < 2; ++a)
#pragma unroll
            for (int b = 0; b < 2; ++b)
#pragma unroll
                for (int m = 0; m < 4; ++m)
#pragma unroll
                    for (int n = 0; n < 2; ++n) acc[a][b][m][n] = (f32x4){0.f, 0.f, 0.f, 0.f};
        cur = nxt; cA = nA; cB = nB; ++ui;
        if constexpr (ALIGN_EPI) { if (wr == 1) PG8_BAR; }
    }
    PG8_WAIT_V(0);
    if constexpr (!ALIGN_EPI) { if (wr == 0) PG8_BAR; }
    PG8_BAR;
    if constexpr (Epi::AFTER_DRAIN) { E.fused(acc, cur, wr, wc, fr, fq, lds, wid, lane); S.done(cur); }
#undef PG8_SA
#undef PG8_SB
#undef PG8_STAGE
#undef PG8_LDA
#undef PG8_LDB
#undef PG8_MMA
#undef PG8_WAIT_V
#undef PG8_WAIT_L
#undef PG8_BAR
#undef PG8_SCHED
}
}
#ifndef DUPMASK
#define DUPMASK 0
#endif
#define NREP(k) (1 + ((DUPMASK >> (k)) & 1))
#define GSYNC() do { for (int rs_ = 0; rs_ < NREP(9); ++rs_) xcd_barrier(bar); } while (0)
constexpr int NWAVES = 8;
constexpr int T = 32768, D = 1024, FF = 2816, SEQ = 4096, NBATCH = 8, MEMLEN = 256, MEMROWS = NBATCH * MEMLEN;
constexpr int EV_IN = 2304, OD_IN = 2048, XAW = 512;
#define GAS __attribute__((address_space(1)))
#define LAS __attribute__((address_space(3)))
typedef unsigned short bf16;
typedef unsigned v4u __attribute__((ext_vector_type(4)));
typedef unsigned v2u __attribute__((ext_vector_type(2)));
typedef float f32x4 __attribute__((ext_vector_type(4)));
#define LDS_WAIT() asm volatile("s_waitcnt lgkmcnt(0)" ::: "memory")
__device__ __forceinline__ unsigned f2bf(float f) { unsigned u = __builtin_bit_cast(unsigned, f); return (u + 0x7fffu + ((u >> 16) & 1u)) >> 16; }
__device__ __forceinline__ unsigned pk2(float lo, float hi) { return f2bf(lo) | (f2bf(hi) << 16); }
__device__ __forceinline__ float bflo(unsigned w) { return __uint_as_float(w << 16); }
__device__ __forceinline__ float bfhi(unsigned w) { return __uint_as_float(w & 0xffff0000u); }
__device__ __forceinline__ float bf1(bf16 b) { return __uint_as_float((unsigned)b << 16); }
__device__ __forceinline__ float wave_sum(float v) {
#pragma unroll
    for (int o = 1; o < 64; o <<= 1) v += __shfl_xor(v, o);
    return v;
}
__device__ __forceinline__ int rel_bucket(int n) {
    if (n < 16) return n;
    int b = 16;
    b += (n >= 19); b += (n >= 21); b += (n >= 24); b += (n >= 27); b += (n >= 31); b += (n >= 35); b += (n >= 40); b += (n >= 46);
    b += (n >= 52); b += (n >= 59); b += (n >= 67); b += (n >= 77); b += (n >= 87); b += (n >= 99); b += (n >= 113);
    return b;
}

constexpr size_t MiB = 1u << 20;
constexpr size_t WS_TAB = 0;
constexpr int TABW = 256, TPAD = 32;
constexpr size_t WS_KSUM = 64 * 1024;
constexpr size_t WS_BAR = 16 * 1024;
constexpr size_t WS_SS = 448 * MiB;
constexpr size_t WS_W = 4 * MiB;
constexpr size_t W_GU = (size_t)2 * FF * D, W_DN = (size_t)D * FF;
constexpr size_t WO_GU1 = 0, WO_DN1 = WO_GU1 + 2 * W_GU, WO_GU2 = WO_DN1 + 2 * W_DN, WO_DN2 = WO_GU2 + 2 * W_GU;
constexpr size_t WO_EVIN = WO_DN2 + 2 * W_DN, WO_EVOUT = WO_EVIN + (size_t)EV_IN * D, WO_ODIN = WO_EVOUT + (size_t)D * D, WO_ODOUT = WO_ODIN + (size_t)OD_IN * D;
constexpr size_t WO_XQ = WO_ODOUT + (size_t)D * D, WO_XKV = WO_XQ + 2 * (size_t)XAW * D, WO_XO = WO_XKV + (size_t)2 * 1024 * D, WO_END = WO_XO + 2 * (size_t)D * XAW;
static_assert(WO_END * 2 <= 96 * MiB, "weights fit");
constexpr size_t WS_MEMN = 100 * MiB;
constexpr size_t WS_XKP = 104 * MiB, WS_XVP = 108 * MiB;
constexpr size_t WS_XB = 112 * MiB;
constexpr size_t WS_Y = 176 * MiB;
constexpr size_t WS_R1 = 240 * MiB;
constexpr size_t WS_XQ = WS_R1, WS_XO = WS_R1 + 32 * MiB;
constexpr size_t WS_KPAN = WS_R1 + 144 * MiB;
constexpr size_t WS_VPAN = WS_R1 + 176 * MiB;
constexpr size_t WS_END = WS_VPAN + 32 * MiB + 20 * MiB;
constexpr size_t WS_XDUMMY = WS_Y;

constexpr int LDS_BYTES = 147456, LDS_TAB_OFF = 131072, LDS_BARST_OFF = 131072 + 8192;

struct Args { const float* in[24]; float* out; unsigned char* ws; };

struct Job { const float* src; const float* gain; bf16* dst; int K, N, mode; };
__device__ __forceinline__ Job get_job(int j, const Args& a, bf16* W) {
    Job b; b.gain = nullptr; b.mode = 0;
    if (j < 18) { const int l = j / 9, r = j % 9;
        switch (r) {
        case 0: b.src = a.in[3] + (size_t)l * D * FF; b.gain = a.in[2] + l * D; b.dst = W + WO_GU1 + l * W_GU; b.K = D; b.N = FF; b.mode = 1; break;
        case 1: b.src = a.in[4] + (size_t)l * D * FF; b.gain = a.in[2] + l * D; b.dst = W + WO_GU1 + l * W_GU; b.K = D; b.N = FF; b.mode = 2; break;
        case 2: b.src = a.in[5] + (size_t)l * D * FF; b.dst = W + WO_DN1 + l * W_DN; b.K = FF; b.N = D; break;
        case 3: b.src = a.in[20] + (size_t)l * D * FF; b.gain = a.in[19] + l * D; b.dst = W + WO_GU2 + l * W_GU; b.K = D; b.N = FF; b.mode = 1; break;
        case 4: b.src = a.in[21] + (size_t)l * D * FF; b.gain = a.in[19] + l * D; b.dst = W + WO_GU2 + l * W_GU; b.K = D; b.N = FF; b.mode = 2; break;
        case 5: b.src = a.in[22] + (size_t)l * D * FF; b.dst = W + WO_DN2 + l * W_DN; b.K = FF; b.N = D; break;
        case 6: b.src = a.in[15] + (size_t)l * D * XAW; b.gain = a.in[14] + l * D; b.dst = W + WO_XQ + (size_t)l * XAW * D; b.K = D; b.N = XAW; break;
        case 7: b.src = a.in[16] + (size_t)l * D * 1024; b.dst = W + WO_XKV + (size_t)l * 1024 * D; b.K = D; b.N = 1024; break;
        default: b.src = a.in[17] + (size_t)l * XAW * D; b.dst = W + WO_XO + (size_t)l * D * XAW; b.K = XAW; b.N = D; break;
        }
    } else {
        switch (j) {
        case 18: b.src = a.in[7]; b.gain = a.in[6]; b.dst = W + WO_EVIN; b.K = D; b.N = EV_IN; break;
        case 19: b.src = a.in[10]; b.dst = W + WO_EVOUT; b.K = D; b.N = D; break;
        case 20: b.src = a.in[11]; b.gain = a.in[6] + D; b.dst = W + WO_ODIN; b.K = D; b.N = OD_IN; break;
        default: b.src = a.in[12]; b.dst = W + WO_ODOUT; b.K = D; b.N = D; break;
        }
    }
    return b;
}
__device__ __forceinline__ void transpose_item(const Job& jb, LAS float* scr, int item, int lane) {
    const int K = jb.K, N = jb.N; const int nblk = N / 32, kb = item / nblk, nb = item % nblk, k0 = 64 * kb, n0 = 32 * nb;
    int r0 = n0; if (jb.mode) r0 = 256 * (n0 / 128) + (n0 % 128) + (jb.mode == 2 ? 128 : 0);
#pragma unroll
    for (int i = 0; i < 8; ++i) { const int kk = 8 * i + (lane >> 3), c4 = 4 * (lane & 7); const float g = jb.gain ? jb.gain[k0 + kk] : 1.0f;
        const f32x4 v = *(const f32x4*)(jb.src + (size_t)(k0 + kk) * N + n0 + c4); LAS float* d = scr + kk * 33 + c4;
        d[0] = v.x * g; d[1] = v.y * g; d[2] = v.z * g; d[3] = v.w * g; }
    LDS_WAIT(); asm volatile("" ::: "memory");
    const int c = lane & 7;
#pragma unroll
    for (int j = 0; j < 4; ++j) { const int n = (lane >> 3) + 8 * j; const LAS float* s = scr + (8 * c) * 33 + n;
        v4u o; o.x = pk2(s[0 * 33], s[1 * 33]); o.y = pk2(s[2 * 33], s[3 * 33]); o.z = pk2(s[4 * 33], s[5 * 33]); o.w = pk2(s[6 * 33], s[7 * 33]);
        *(v4u*)(jb.dst + (size_t)(r0 + n) * K + k0 + 8 * c) = o; }
    LDS_WAIT(); asm volatile("" ::: "memory");
}
constexpr int N_JOB_ITEMS = 2 * (6 * 1408 + 256 + 512 + 256) + 1152 + 512 + 1024 + 512;


#define XB_TMO      128
#define XB_XCNT(j)  (256  + 64 * (j))
#define XB_XSUB(j)  (1280 + 64 * (j))
#define XB_XGEN(j)  (2304 + 64 * (j))
#define XB_TOP      3328
#define XB_TOPGEN   3392
#define XCD_BAR_WORDS 3456
#define XB_SPIN_CAP (1u << 18)

__device__ __forceinline__ unsigned xb_ld(unsigned* p)              { return __hip_atomic_load(p, __ATOMIC_RELAXED, __HIP_MEMORY_SCOPE_AGENT); }
__device__ __forceinline__ unsigned xb_add(unsigned* p, unsigned v) { return __hip_atomic_fetch_add(p, v, __ATOMIC_RELAXED, __HIP_MEMORY_SCOPE_AGENT); }
__device__ __forceinline__ unsigned xb_xcc_id() { return (unsigned)__builtin_amdgcn_s_getreg((3 << 11) | 20) & 0xFu; }
#define XB_SPIN(cond, bar) do { unsigned _sp = 0; while (cond) { __builtin_amdgcn_s_sleep(1); \
    if ((++_sp & 255u) == 0u) { if (xb_ld(&(bar)[XB_TMO])) break; if (_sp > XB_SPIN_CAP) { atomicAdd(&(bar)[XB_TMO], 1u); break; } } } } while (0)

struct XcdBarrier {
    unsigned* bar; unsigned x;
    volatile LAS unsigned* st;
};

__device__ __forceinline__ XcdBarrier xcd_barrier_post(unsigned* bar, volatile LAS unsigned* st) {
    XcdBarrier b; b.bar = bar; b.x = xb_xcc_id(); b.st = st;
    if (threadIdx.x == 0) (void)xb_add(&bar[XB_XCNT(b.x)], 1u);
    return b;
}
__device__ __forceinline__ void xcd_barrier_complete(unsigned* bar, unsigned x, unsigned& nloc, unsigned& nx) {
    const unsigned G = gridDim.x * gridDim.y * gridDim.z;
    unsigned sum, cnt, mine, sp = 0u;
    for (;;) {
        sum = 0u; cnt = 0u; mine = 0u;
#pragma unroll
        for (unsigned j = 0; j < 16; ++j) { const unsigned c = xb_ld(&bar[XB_XCNT(j)]); sum += c; cnt += (c > 0u) ? 1u : 0u; mine = (j == x) ? c : mine; }
        if (sum == G) break;
        __builtin_amdgcn_s_sleep(1);
        if ((++sp & 255u) == 0u) { if (xb_ld(&bar[XB_TMO])) break; if (sp > XB_SPIN_CAP) { atomicAdd(&bar[XB_TMO], 1u); break; } }
    }
    nloc = mine > 0u ? mine : 1u; nx = cnt > 0u ? cnt : 1u;
}

__device__ __forceinline__ void xcd_barrier(const XcdBarrier& b) {
    asm volatile("s_waitcnt vmcnt(0)" ::: "memory");
    __syncthreads();
    if (threadIdx.x == 0) {
        unsigned* bar = b.bar;
        __builtin_amdgcn_s_waitcnt(0);
        unsigned nloc = b.st[0], nx = b.st[1];
        if (nloc == 0u) { xcd_barrier_complete(bar, b.x, nloc, nx); b.st[0] = nloc; b.st[1] = nx; }
        const unsigned old = xb_add(&bar[XB_XSUB(b.x)], 1u);
        const unsigned gen = old / nloc;
        if (old + 1u == (gen + 1u) * nloc) {
            __builtin_amdgcn_fence(__ATOMIC_RELEASE, "agent");
            asm volatile("s_waitcnt vmcnt(0)" ::: "memory");
            const unsigned og = xb_add(&bar[XB_TOP], 1u);
            const unsigned tg = og / nx;
            if (og + 1u == (tg + 1u) * nx) xb_add(&bar[XB_TOPGEN], 1u);
            else XB_SPIN(xb_ld(&bar[XB_TOPGEN]) == tg, bar);
            __builtin_amdgcn_fence(__ATOMIC_ACQUIRE, "agent");
            xb_add(&bar[XB_XGEN(b.x)], 1u);
            asm volatile("s_waitcnt vmcnt(0)" ::: "memory");
        } else {
            XB_SPIN(xb_ld(&bar[XB_XGEN(b.x)]) == gen, bar);
            __builtin_amdgcn_fence(__ATOMIC_ACQUIRE, "agent");
            asm volatile("s_waitcnt vmcnt(0)" ::: "memory");
        }
    }
    __syncthreads();
}

typedef short bf16x8 __attribute__((ext_vector_type(8)));
typedef float f32x16 __attribute__((ext_vector_type(16)));
#define MFMA32(a, b, c) __builtin_amdgcn_mfma_f32_32x32x16_bf16((a), (b), (c), 0, 0, 0)
using pg8::cvtpk;
constexpr float LOG2E = 1.4426950408889634f;
__device__ __forceinline__ constexpr int kofs(int i) { return (i & 3) + 4 * ((i >> 2) & 1) + 16 * (i >> 3); }
template <int DH, class LF>
__device__ __forceinline__ void attn_run(const bf16* kb, const bf16* vb, int t0, int t1, const bf16x8 (&qf)[DH / 16], f32x16 (&o)[DH / 32], float& m_run, float& l_run, LF&& lf) {
    constexpr int KS = DH / 16, ND = DH / 32, TS = 32 * DH;
    bf16x8 kf[KS];
#pragma unroll
    for (int s = 0; s < KS; ++s) kf[s] = *(const bf16x8*)(kb + s * 512);
#pragma unroll 1
    for (int t = t0; t <= t1; ++t) {
        bf16x8 vf[2][ND];
#pragma unroll
        for (int s2 = 0; s2 < 2; ++s2)
#pragma unroll
            for (int dg = 0; dg < ND; ++dg) vf[s2][dg] = *(const bf16x8*)(vb + s2 * (2 * DH * 8) + dg * 256);
        f32x16 st;
#pragma unroll
        for (int i = 0; i < 16; ++i) st[i] = 0.f;
#pragma unroll
        for (int s = 0; s < KS; ++s) st = MFMA32(kf[s], qf[s], st);
        if (t < t1) kb += TS;
        vb += TS;
#pragma unroll
        for (int s = 0; s < KS; ++s) kf[s] = *(const bf16x8*)(kb + s * 512);
        lf(t, st);
        float tmax = fmaxf(fmaxf(st[0], st[1]), st[2]);
#pragma unroll
        for (int i = 3; i < 15; i += 2) tmax = fmaxf(fmaxf(tmax, st[i]), st[i + 1]);
        tmax = fmaxf(tmax, st[15]);
        { auto rr_ = __builtin_amdgcn_permlane32_swap(__float_as_uint(tmax), __float_as_uint(tmax), false, false); tmax = fmaxf(__uint_as_float(rr_[0]), __uint_as_float(rr_[1])); }
        if (__any(tmax > m_run + 8.0f)) {
            const float mn = fmaxf(m_run, tmax), corr = __builtin_amdgcn_exp2f(m_run - mn); m_run = mn; l_run *= corr;
#pragma unroll
            for (int dg = 0; dg < ND; ++dg) o[dg] = o[dg] * corr;
        }
        st = st - m_run;
#pragma unroll
        for (int i = 0; i < 16; ++i) st[i] = __builtin_amdgcn_exp2f(st[i]);
        { float ps = ((st[0] + st[1]) + (st[2] + st[3])) + ((st[4] + st[5]) + (st[6] + st[7])) + ((st[8] + st[9]) + (st[10] + st[11])) + ((st[12] + st[13]) + (st[14] + st[15]));
          { auto rr_ = __builtin_amdgcn_permlane32_swap(__float_as_uint(ps), __float_as_uint(ps), false, false); ps = __uint_as_float(rr_[0]) + __uint_as_float(rr_[1]); } l_run += ps; }
        v4u p0, p1; p0.x = cvtpk(st[0], st[1]); p0.y = cvtpk(st[2], st[3]); p0.z = cvtpk(st[4], st[5]); p0.w = cvtpk(st[6], st[7]);
        p1.x = cvtpk(st[8], st[9]); p1.y = cvtpk(st[10], st[11]); p1.z = cvtpk(st[12], st[13]); p1.w = cvtpk(st[14], st[15]);
        const bf16x8 pf0 = __builtin_bit_cast(bf16x8, p0), pf1 = __builtin_bit_cast(bf16x8, p1);
#pragma unroll
        for (int dg = 0; dg < ND; ++dg) { o[dg] = MFMA32(vf[0][dg], pf0, o[dg]); o[dg] = MFMA32(vf[1][dg], pf1, o[dg]); }
    }
}

template <int DH, class LF, class VF>
__device__ __forceinline__ void attn_tile_tail(int t, f32x16& st, f32x16 (&o)[DH / 32], float& m_run, float& l_run, LF&& lf, VF&& vfrag) {
    constexpr int ND = DH / 32;
    lf(t, st);
    for (int vr_ = 1; vr_ < NREP(13); ++vr_) { f32x16 d_ = st; asm volatile("" : "+v"(d_)); float dm_ = fmaxf(fmaxf(d_[0], d_[1]), d_[2]);
#pragma unroll
        for (int i = 3; i < 15; i += 2) dm_ = fmaxf(fmaxf(dm_, d_[i]), d_[i + 1]);
        dm_ = fmaxf(dm_, __shfl_xor(dm_, 32)); d_ = d_ - dm_;
#pragma unroll
        for (int i = 0; i < 16; ++i) d_[i] = __builtin_amdgcn_exp2f(d_[i]);
        float ds_ = 0.f;
#pragma unroll
        for (int i = 0; i < 16; ++i) ds_ += d_[i];
        ds_ += __shfl_xor(ds_, 32); unsigned dp_ = 0;
#pragma unroll
        for (int i = 0; i < 16; i += 2) dp_ ^= cvtpk(d_[i], d_[i + 1]);
        asm volatile("" :: "v"(ds_), "v"(dp_)); }
    float tmax = fmaxf(fmaxf(st[0], st[1]), st[2]);
#pragma unroll
    for (int i = 3; i < 15; i += 2) tmax = fmaxf(fmaxf(tmax, st[i]), st[i + 1]);
    tmax = fmaxf(tmax, st[15]);
    { auto rr_ = __builtin_amdgcn_permlane32_swap(__float_as_uint(tmax), __float_as_uint(tmax), false, false); tmax = fmaxf(__uint_as_float(rr_[0]), __uint_as_float(rr_[1])); }
    if (__any(tmax > m_run + 8.0f)) {
        const float mn = fmaxf(m_run, tmax), corr = __builtin_amdgcn_exp2f(m_run - mn); m_run = mn; l_run *= corr;
#pragma unroll
        for (int dg = 0; dg < ND; ++dg) o[dg] = o[dg] * corr;
    }
    st = st - m_run;
#pragma unroll
    for (int i = 0; i < 16; ++i) st[i] = __builtin_amdgcn_exp2f(st[i]);
    { float ps = ((st[0] + st[1]) + (st[2] + st[3])) + ((st[4] + st[5]) + (st[6] + st[7])) + ((st[8] + st[9]) + (st[10] + st[11])) + ((st[12] + st[13]) + (st[14] + st[15]));
      { auto rr_ = __builtin_amdgcn_permlane32_swap(__float_as_uint(ps), __float_as_uint(ps), false, false); ps = __uint_as_float(rr_[0]) + __uint_as_float(rr_[1]); } l_run += ps; }
    v4u p0, p1; p0.x = cvtpk(st[0], st[1]); p0.y = cvtpk(st[2], st[3]); p0.z = cvtpk(st[4], st[5]); p0.w = cvtpk(st[6], st[7]);
    p1.x = cvtpk(st[8], st[9]); p1.y = cvtpk(st[10], st[11]); p1.z = cvtpk(st[12], st[13]); p1.w = cvtpk(st[14], st[15]);
    const bf16x8 pf0 = __builtin_bit_cast(bf16x8, p0), pf1 = __builtin_bit_cast(bf16x8, p1);
#pragma unroll
    for (int dg = 0; dg < ND; ++dg) { o[dg] = MFMA32(vfrag(0, dg), pf0, o[dg]); o[dg] = MFMA32(vfrag(1, dg), pf1, o[dg]); }
    for (int pr_ = 1; pr_ < NREP(14); ++pr_) { bf16x8 z_ = {0, 0, 0, 0, 0, 0, 0, 0}; asm volatile("" : "+v"(z_));
#pragma unroll
        for (int dg = 0; dg < ND; ++dg) { o[dg] = MFMA32(vfrag(0, dg), z_, o[dg]); o[dg] = MFMA32(vfrag(1, dg), z_, o[dg]); } }
}
template <int DH>
__device__ __forceinline__ void attn_store(bf16* orow, const f32x16 (&o)[DH / 32], float l_run, int h) {
    const float il = 1.0f / l_run;
#pragma unroll
    for (int dg = 0; dg < DH / 32; ++dg)
#pragma unroll
        for (int g = 0; g < 4; g += 2) {
            unsigned ax = cvtpk(o[dg][4 * g] * il, o[dg][4 * g + 1] * il), ay = cvtpk(o[dg][4 * g + 2] * il, o[dg][4 * g + 3] * il);
            unsigned bx = cvtpk(o[dg][4 * g + 4] * il, o[dg][4 * g + 5] * il), by = cvtpk(o[dg][4 * g + 6] * il, o[dg][4 * g + 7] * il);
            { auto rr = __builtin_amdgcn_permlane32_swap(ax, bx, false, false); ax = rr[0]; bx = rr[1]; }
            { auto rr = __builtin_amdgcn_permlane32_swap(ay, by, false, false); ay = rr[0]; by = rr[1]; }
            v4u w; w.x = ax; w.y = ay; w.z = bx; w.w = by;
            *(v4u*)(orow + dg * 32 + 8 * g + 8 * h) = w; }
}
#define TOP3_INSERT(g, n) do { if ((g) > s0) { s2 = s1; i2 = i1; s1 = s0; i1 = i0; s0 = (g); i0 = (n); } else if ((g) > s1) { s2 = s1; i2 = i1; s1 = (g); i1 = (n); } else if ((g) > s2) { s2 = (g); i2 = (n); } } while (0)

__device__ __forceinline__ void build_bias_table(LAS unsigned char* lds, const float* rel_bias, bool window) {
    for (int i = threadIdx.x; i < 8 * TABW; i += NWAVES * 64) { const int h = i / TABW, k = i % TABW, d = k - TPAD;
        float v = -INFINITY;
        if (d >= 0 && d < 128) v = rel_bias[rel_bucket(d) * 8 + h] * LOG2E; else if (d >= 128 && !window) v = rel_bias[31 * 8 + h] * LOG2E;
        ((LAS float*)(lds + LDS_TAB_OFF))[i] = v; }
}
template <int l> __device__ __forceinline__ void layer_body(const Args& args, LAS unsigned char* lds, const XcdBarrier& bar) {
    int tid_ = threadIdx.x; asm volatile("" : "+v"(tid_));
    const int tid = tid_, lane = tid & 63, wave = __builtin_amdgcn_readfirstlane(tid >> 6);
    const int G = gridDim.x, bx = blockIdx.x;
    unsigned char* ws = args.ws;
    float* KSUM = (float*)(ws + WS_KSUM); float* SS = (float*)(ws + WS_SS);
    bf16* W = (bf16*)(ws + WS_W); bf16* XKP = (bf16*)(ws + WS_XKP); bf16* XVP = (bf16*)(ws + WS_XVP); bf16* KPAN = (bf16*)(ws + WS_KPAN); bf16* VPAN = (bf16*)(ws + WS_VPAN);
    const LAS float* tabl = (const LAS float*)(lds + LDS_TAB_OFF); const int r = lane & 31, hh = lane >> 5, pr = (r & ~12) | ((r & 4) << 1) | ((r & 8) >> 1);
    bf16* XB = (bf16*)(ws + WS_XB); bf16* Y = (bf16*)(ws + WS_Y); bf16* R1 = (bf16*)(ws + WS_R1); bf16* XQ = (bf16*)(ws + WS_XQ); bf16* XO = (bf16*)(ws + WS_XO);
    const float* x_in = args.in[0]; float* OUT = args.out;
        float* ssl = SS + (size_t)(4 * l) * T * 2; constexpr size_t TS16 = (size_t)T * 2;
        for (int rep = 0; rep < NREP(0); ++rep) { pg8::Gemm g{XB, W + WO_GU1 + l * W_GU, T, 2 * FF, D}; pg8::StaticOrder S; S.init(T, 2 * FF, G, bx);
          pg8::EpiSwiglu E{R1, FF, ssl};
          pg8::gemm_phase<pg8::EpiSwiglu, pg8::StaticOrder, true, true>(lds, g, S, E); }
        GSYNC();
        for (int rep = 0; rep < NREP(1); ++rep) { const bool fin = rep == NREP(1) - 1; pg8::Gemm g{R1, W + WO_DN1 + l * W_DN, T, D, FF}; pg8::StaticOrder S; S.init(T, D, G, bx);
          pg8::EpiResid E{l == 0 ? x_in : nullptr, XB, fin ? ssl + TS16 : SS + 9 * TS16, fin ? 0.5f : 0.0f};
          pg8::gemm_phase<pg8::EpiResid, pg8::StaticOrder, true, true>(lds, g, S, E); }
        GSYNC();
        const int NIN = (l == 0) ? EV_IN : OD_IN;
        for (int rep = 0; rep < NREP(2); ++rep) { pg8::Gemm g{XB, W + (l == 0 ? WO_EVIN : WO_ODIN), T, NIN, D}; pg8::StaticOrder S; S.init(T, NIN, G, bx);
          pg8::EpiQKV E{R1, NIN, ssl + TS16, KPAN, VPAN, l == 0 ? 2048 : 1024, l == 0 ? 2176 : 1536, l == 0 ? 6 : 7, l == 0 ? 2 : 4, 12, l == 0 ? nullptr : KSUM};
          pg8::gemm_phase<pg8::EpiQKV, pg8::StaticOrder, true, true>(lds, g, S, E); }
        if (l == 0) {
#pragma unroll
            for (int lk = 0; lk < 2; ++lk) { pg8::Gemm g{(const bf16*)(ws + WS_MEMN), W + WO_XKV + (size_t)lk * 1024 * D, MEMROWS, 1024, D}; pg8::StaticOrder S; S.init(MEMROWS, 1024, G, (bx + G - (128 + 32 * lk) % G) % G);
              pg8::EpiQKV E{nullptr, 0, nullptr, XKP + (size_t)lk * 32 * 8 * 4096, XVP + (size_t)lk * 32 * 8 * 4096, 0, 512, 7, 4, 8, nullptr};
              pg8::gemm_phase<pg8::EpiQKV, pg8::StaticOrder, true, true>(lds, g, S, E); }
        }
        GSYNC();
        if (l == 0) {
            const bf16* Z = R1; const float* cw = args.in[8];
            for (int rep = 0; rep < NREP(3); ++rep) for (int w = bx; w < T / 128; w += G) {
                { const int c = (tid & 63) * 8;
                  const f32x4 wa0 = *(const f32x4*)(cw + c), wa1 = *(const f32x4*)(cw + c + 4), wb0 = *(const f32x4*)(cw + 512 + c), wb1 = *(const f32x4*)(cw + 512 + c + 4), wc0 = *(const f32x4*)(cw + 1024 + c), wc1 = *(const f32x4*)(cw + 1024 + c + 4);
#define CONV2(k, W0a, W0b, W1a, W1b, W2a, W2b) cvtpk(bflo(bg[q_][k]) * ((W2a) * bflo(c0[q_][k]) * bflo(u0[q_][k]) + (W1a) * bflo(c1[q_][k]) * bflo(u1[q_][k]) + (W0a) * bflo(c2[q_][k]) * bflo(u2[q_][k])), \
                                                      bfhi(bg[q_][k]) * ((W2b) * bfhi(c0[q_][k]) * bfhi(u0[q_][k]) + (W1b) * bfhi(c1[q_][k]) * bfhi(u1[q_][k]) + (W0b) * bfhi(c2[q_][k]) * bfhi(u2[q_][k])))
                  for (int i = 0; i < 16; i += 2) { v4u bg[2], c0[2], u0[2], c1[2], u1[2], c2[2], u2[2];
#pragma unroll
                    for (int q_ = 0; q_ < 2; ++q_) { const int t = w * 128 + (tid >> 6) + 8 * (i + q_), pos = t & (SEQ - 1); const bf16* zr = Z + (size_t)t * EV_IN + c;
                        bg[q_] = *(const v4u*)zr; c0[q_] = *(const v4u*)(zr + 512); u0[q_] = *(const v4u*)(zr + 1024);
                        c1[q_] = (v4u){0, 0, 0, 0}; u1[q_] = (v4u){0, 0, 0, 0}; c2[q_] = (v4u){0, 0, 0, 0}; u2[q_] = (v4u){0, 0, 0, 0};
                        if (pos >= 1) { c1[q_] = *(const v4u*)(zr + 512 - EV_IN); u1[q_] = *(const v4u*)(zr + 1024 - EV_IN); }
                        if (pos >= 2) { c2[q_] = *(const v4u*)(zr + 512 - 2 * EV_IN); u2[q_] = *(const v4u*)(zr + 1024 - 2 * EV_IN); } }
#pragma unroll
                    for (int q_ = 0; q_ < 2; ++q_) { const int t = w * 128 + (tid >> 6) + 8 * (i + q_); v4u o;
                        o.x = CONV2(0, wa0[0], wa0[1], wb0[0], wb0[1], wc0[0], wc0[1]); o.y = CONV2(1, wa0[2], wa0[3], wb0[2], wb0[3], wc0[2], wc0[3]);
                        o.z = CONV2(2, wa1[0], wa1[1], wb1[0], wb1[1], wc1[0], wc1[1]); o.w = CONV2(3, wa1[2], wa1[3], wb1[2], wb1[3], wc1[2], wc1[3]);
                        *(v4u*)(Y + (size_t)t * D + c) = o; } }
#undef CONV2
                }
                const int hd = wave, kvh = hd >> 2; const float sink2 = args.in[9][hd] * LOG2E; const LAS float* tb = tabl + hd * TABW;
                for (int jj = 0; jj < 4; ++jj) { const int qt = w * 4 + jj, b = qt >> 7, j = qt & 127, q0g = qt * 32;
                    bf16x8 qf[4];
#pragma unroll
                    for (int s = 0; s < 4; ++s) qf[s] = *(const bf16x8*)(Z + (size_t)(q0g + r) * EV_IN + 1536 + hd * 64 + 16 * s + 8 * hh);
                    f32x16 o[2];
#pragma unroll
                    for (int i = 0; i < 16; ++i) { o[0][i] = 0.f; o[1][i] = 0.f; }
                    float m_run = sink2, l_run = 1.0f;
                    const int t0 = j >= 4 ? j - 4 : 0; const size_t tb0 = ((size_t)(b * 2 + kvh) * 128 + t0) * 2048;
                    const int qpos = j * 32 + r;
                    attn_run<64>(KPAN + tb0 + (hh * 32 + pr) * 8, VPAN + tb0 + (hh * 64 + r) * 8, t0, j, qf, o, m_run, l_run, [&](int t, f32x16& st) {
                        const LAS float* bp = tb + (TPAD - 23) + (qpos - t * 32 - 8 * hh);
#pragma unroll
                        for (int i = 0; i < 16; ++i) st[i] = __builtin_fmaf(st[i], 0.125f * LOG2E, bp[23 - kofs(i)]); });
                    attn_store<64>(Y + (size_t)(q0g + r) * D + 512 + hd * 64, o, l_run, hh); }
            }
        } else {
            const bf16* Z = R1;
            build_bias_table(lds, args.in[13], false); __syncthreads();
            const LAS float* tb0_ = tabl; const float scale2 = 0.08838834764831845f * LOG2E;
            for (int rep = 0; rep < NREP(4); ++rep) for (int w = bx; w < 256; w += G) { const int b = w & 7, kvh = (w >> 3) & 3, uu = w >> 5;
                for (int jj = 0; jj < 4; ++jj) { const int jg = (jj == 0) ? uu : (jj == 1) ? 15 - uu : (jj == 2) ? 16 + uu : 31 - uu;
                    const int j = jg * 4 + (wave >> 1), jmax = jg * 4 + 3, hd = kvh * 2 + (wave & 1), own = j >> 3, q0g = b * SEQ + j * 32;
                    const LAS float* tb = tb0_ + hd * TABW; const float b128 = tb[TPAD + 128];
                    const bf16* kgu = KPAN + (size_t)(b * 4 + kvh) * 128 * 4096; const bf16* vgu = VPAN + (size_t)(b * 4 + kvh) * 128 * 4096; const unsigned so = (unsigned)tid * 8u;
#define DMA16(gsrc, ldsoff) __builtin_amdgcn_global_load_lds((const unsigned*)(gsrc), (LAS unsigned*)(lds + (ldsoff) + wave * 1024), 16, 0, 0)
#define DMA_PAIR(u_, pb_) do { DMA16(kgu + (size_t)(2 * (u_)) * 4096 + so, (pb_)); DMA16(kgu + (size_t)(2 * (u_) + 1) * 4096 + so, (pb_) + 8192); DMA16(vgu + (size_t)(2 * (u_)) * 4096 + so, 32768 + (pb_)); DMA16(vgu + (size_t)(2 * (u_) + 1) * 4096 + so, 32768 + (pb_) + 8192); } while (0)
                    DMA_PAIR(0, 0);
                    bf16x8 qf[8];
#pragma unroll
                    for (int s = 0; s < 8; ++s) qf[s] = *(const bf16x8*)(Z + (size_t)(q0g + r) * OD_IN + hd * 128 + 16 * s + 8 * hh);
                    unsigned selmask = 0u;
                    if (own > 0) {
                        f32x16 gt;
#pragma unroll
                        for (int i = 0; i < 16; ++i) gt[i] = 0.f;
                        const long long* ks = (const long long*)KSUM + ((size_t)(b * 4 + kvh) * 16 + (r & 15)) * 128 + 8 * hh;
#pragma unroll
                        for (int s = 0; s < 8; ++s) { f32x4 a0, a1;
#pragma unroll
                            for (int e = 0; e < 4; ++e) { a0[e] = (float)ks[16 * s + e] * (1.0f / 4294967296.0f); a1[e] = (float)ks[16 * s + 4 + e] * (1.0f / 4294967296.0f); }
                            v4u hi; hi.x = cvtpk(a0[0], a0[1]); hi.y = cvtpk(a0[2], a0[3]); hi.z = cvtpk(a1[0], a1[1]); hi.w = cvtpk(a1[2], a1[3]);
                            v4u lo; lo.x = cvtpk(a0[0] - bflo(hi.x), a0[1] - bfhi(hi.x)); lo.y = cvtpk(a0[2] - bflo(hi.y), a0[3] - bfhi(hi.y)); lo.z = cvtpk(a1[0] - bflo(hi.z), a1[1] - bfhi(hi.z)); lo.w = cvtpk(a1[2] - bflo(hi.w), a1[3] - bfhi(hi.w));
                            gt = MFMA32(__builtin_bit_cast(bf16x8, hi), qf[s], gt); gt = MFMA32(__builtin_bit_cast(bf16x8, lo), qf[s], gt); }
                        float glo[8], ghi[8];
#pragma unroll
                        for (int i = 0; i < 8; ++i) { const float mine = gt[i], oth = __shfl_xor(mine, 32); glo[i] = hh ? oth : mine; ghi[i] = hh ? mine : oth; }
                        float s0 = -INFINITY, s1 = -INFINITY, s2 = -INFINITY; int i0 = -1, i1 = -1, i2 = -1;
#pragma unroll
                        for (int n = 0; n < 16; ++n) { const float g = (n & 4) ? ghi[(n & 3) + 4 * (n >> 3)] : glo[(n & 3) + 4 * (n >> 3)]; if (n < own) TOP3_INSERT(g, n); }
                        selmask = (i0 >= 0 ? 1u << i0 : 0u) | (i1 >= 0 ? 1u << i1 : 0u) | (i2 >= 0 ? 1u << i2 : 0u);
                    }
                    f32x16 o[4];
#pragma unroll
                    for (int dg = 0; dg < 4; ++dg)
#pragma unroll
                        for (int i = 0; i < 16; ++i) o[dg][i] = 0.f;
                    float m_run = -1e30f, l_run = 0.f; const int qpos = j * 32 + r;
                    __syncthreads();
                    const int umax = 2 * jg + 1;
                    auto logits = [&](int tt, f32x16& s_) {
                        const int n = tt >> 3; const bool sel = (n >= own) || ((selmask >> n) & 1u);
                        if (j * 32 - (tt * 32 + 31) >= 128) { const float madd = sel ? b128 : -INFINITY;
#pragma unroll
                            for (int i = 0; i < 16; ++i) { float r_ = __builtin_fmaf(s_[i], scale2, madd); asm volatile("" : "+v"(r_)); s_[i] = r_; } }
                        else { const LAS float* bp = tb + (TPAD - 23) + (qpos - tt * 32 - 8 * hh); const float madd = sel ? 0.0f : -INFINITY;
#pragma unroll
                            for (int i = 0; i < 16; ++i) s_[i] = __builtin_fmaf(s_[i], scale2, bp[23 - kofs(i)] + madd); } };
#pragma unroll 1
                    for (int u = 0; u <= umax; ++u) {
                        if (u < umax) DMA_PAIR(u + 1, ((u + 1) & 1) * 16384);
                        if (2 * u <= j) {
                            const int ta = 2 * u; const bool hasb = (ta + 1 <= j);
                            const LAS bf16* kl = (const LAS bf16*)(lds + (u & 1) * 16384) + (hh * 32 + pr) * 8; const LAS bf16* vl = (const LAS bf16*)(lds + 32768 + (u & 1) * 16384) + (hh * 128 + r) * 8;
                            f32x16 st0, st1;
                            { bf16x8 kfa[8], kfb[8];
#pragma unroll
                              for (int s = 0; s < 8; ++s) { kfa[s] = *(const LAS bf16x8*)(kl + s * 512); kfb[s] = *(const LAS bf16x8*)(kl + 4096 + s * 512); }
#pragma unroll
                              for (int i = 0; i < 16; ++i) { st0[i] = 0.f; st1[i] = 0.f; }
#pragma unroll
                              for (int s = 0; s < 8; ++s) { st0 = MFMA32(kfa[s], qf[s], st0); st1 = MFMA32(kfb[s], qf[s], st1); } }
                            if (hasb) logits(ta + 1, st1);
                            else {
#pragma unroll
                              for (int i = 0; i < 16; ++i) st1[i] = -INFINITY; }
                            logits(ta, st0);
                            float tmax = fmaxf(fmaxf(st0[0], st0[1]), st0[2]);
#pragma unroll
                            for (int i = 3; i < 15; i += 2) tmax = fmaxf(fmaxf(tmax, st0[i]), st0[i + 1]);
                            tmax = fmaxf(tmax, st0[15]);
#pragma unroll
                            for (int i = 0; i < 16; i += 2) tmax = fmaxf(fmaxf(tmax, st1[i]), st1[i + 1]);
                            { auto rr_ = __builtin_amdgcn_permlane32_swap(__float_as_uint(tmax), __float_as_uint(tmax), false, false); tmax = fmaxf(__uint_as_float(rr_[0]), __uint_as_float(rr_[1])); }
                            if (__any(tmax > m_run + 8.0f)) {
                                const float mn = fmaxf(m_run, tmax), corr = __builtin_amdgcn_exp2f(m_run - mn); m_run = mn; l_run *= corr;
#pragma unroll
                                for (int dg = 0; dg < 4; ++dg) o[dg] = o[dg] * corr;
                            }
                            st0 = st0 - m_run; st1 = st1 - m_run;
#pragma unroll
                            for (int i = 0; i < 16; ++i) { st0[i] = __builtin_amdgcn_exp2f(st0[i]); st1[i] = __builtin_amdgcn_exp2f(st1[i]); }
                            { float ps = (((st0[0] + st0[1]) + (st0[2] + st0[3])) + ((st0[4] + st0[5]) + (st0[6] + st0[7]))) + (((st0[8] + st0[9]) + (st0[10] + st0[11])) + ((st0[12] + st0[13]) + (st0[14] + st0[15])));
                              ps += (((st1[0] + st1[1]) + (st1[2] + st1[3])) + ((st1[4] + st1[5]) + (st1[6] + st1[7]))) + (((st1[8] + st1[9]) + (st1[10] + st1[11])) + ((st1[12] + st1[13]) + (st1[14] + st1[15])));
                              { auto rr_ = __builtin_amdgcn_permlane32_swap(__float_as_uint(ps), __float_as_uint(ps), false, false); ps = __uint_as_float(rr_[0]) + __uint_as_float(rr_[1]); }
                              l_run += ps; }
                            { v4u p0, p1; p0.x = cvtpk(st0[0], st0[1]); p0.y = cvtpk(st0[2], st0[3]); p0.z = cvtpk(st0[4], st0[5]); p0.w = cvtpk(st0[6], st0[7]);
                              p1.x = cvtpk(st0[8], st0[9]); p1.y = cvtpk(st0[10], st0[11]); p1.z = cvtpk(st0[12], st0[13]); p1.w = cvtpk(st0[14], st0[15]);
                              const bf16x8 pf0 = __builtin_bit_cast(bf16x8, p0), pf1 = __builtin_bit_cast(bf16x8, p1);
#pragma unroll
                              for (int dg = 0; dg < 4; ++dg) { o[dg] = MFMA32(*(const LAS bf16x8*)(vl + dg * 256), pf0, o[dg]); o[dg] = MFMA32(*(const LAS bf16x8*)(vl + 2048 + dg * 256), pf1, o[dg]); } }
                            { v4u p0, p1; p0.x = cvtpk(st1[0], st1[1]); p0.y = cvtpk(st1[2], st1[3]); p0.z = cvtpk(st1[4], st1[5]); p0.w = cvtpk(st1[6], st1[7]);
                              p1.x = cvtpk(st1[8], st1[9]); p1.y = cvtpk(st1[10], st1[11]); p1.z = cvtpk(st1[12], st1[13]); p1.w = cvtpk(st1[14], st1[15]);
                              const bf16x8 pf0 = __builtin_bit_cast(bf16x8, p0), pf1 = __builtin_bit_cast(bf16x8, p1);
#pragma unroll
                              for (int dg = 0; dg < 4; ++dg) { o[dg] = MFMA32(*(const LAS bf16x8*)(vl + 4096 + dg * 256), pf0, o[dg]); o[dg] = MFMA32(*(const LAS bf16x8*)(vl + 4096 + 2048 + dg * 256), pf1, o[dg]); } }
                        }
                        __syncthreads();
                    }
#undef DMA_PAIR
#undef DMA16
                    attn_store<128>(Y + (size_t)(q0g + r) * D + hd * 128, o, l_run, hh); }
            }
        }
        GSYNC();
        for (int rep = 0; rep < NREP(5); ++rep) { const bool fin = rep == NREP(5) - 1; pg8::Gemm g{Y, W + (l == 0 ? WO_EVOUT : WO_ODOUT), T, D, D}; pg8::StaticOrder S; S.init(T, D, G, bx);
          pg8::EpiResid E{nullptr, XB, fin ? ssl + 2 * TS16 : SS + 9 * TS16, fin ? 1.0f : 0.0f};
          pg8::gemm_phase<pg8::EpiResid, pg8::StaticOrder, true, true>(lds, g, S, E); }
        GSYNC();
        for (int rep = 0; rep < NREP(6); ++rep) { pg8::Gemm g{XB, W + WO_XQ + (size_t)l * XAW * D, T, XAW, D}; pg8::StaticOrder S; S.init(T, XAW, G, bx);
          pg8::EpiScaleBf16 E{XQ, XAW, ssl + 2 * TS16};
          pg8::gemm_phase<pg8::EpiScaleBf16, pg8::StaticOrder, true, true>(lds, g, S, E); }
        GSYNC();
        { const int hd = wave & 3; const float scale2 = 0.08838834764831845f * LOG2E;
          for (int rep = 0; rep < NREP(7); ++rep) for (int w = bx; w < T / 128; w += G)
            for (int jj = 0; jj < 2; ++jj) { const int qt = w * 4 + (wave >> 2) * 2 + jj, b = qt >> 7, q0g = qt * 32;
                bf16x8 qf[8];
#pragma unroll
                for (int s = 0; s < 8; ++s) qf[s] = *(const bf16x8*)(XQ + (size_t)(q0g + r) * XAW + hd * 128 + 16 * s + 8 * hh);
                f32x16 o[4];
#pragma unroll
                for (int dg = 0; dg < 4; ++dg)
#pragma unroll
                    for (int i = 0; i < 16; ++i) o[dg][i] = 0.f;
                float m_run = -1e30f, l_run = 0.f;
                const size_t tb0 = ((size_t)l * 32 + b * 4 + hd) * 8 * 4096;
                attn_run<128>(XKP + tb0 + (hh * 32 + pr) * 8, XVP + tb0 + (hh * 128 + r) * 8, 0, 7, qf, o, m_run, l_run, [&](int t, f32x16& st) {
#pragma unroll
                    for (int i = 0; i < 16; ++i) st[i] *= scale2; });
                attn_store<128>(XO + (size_t)(q0g + r) * XAW + hd * 128, o, l_run, hh); } }
        GSYNC();
        for (int rep = 0; rep < NREP(8); ++rep) { const bool fin = rep == NREP(8) - 1; pg8::Gemm g{XO, W + WO_XO + (size_t)l * D * XAW, T, D, XAW}; pg8::StaticOrder S; S.init(T, D, G, bx);
          pg8::EpiResid E{nullptr, XB, fin ? ssl + 3 * TS16 : SS + 9 * TS16, fin ? 1.0f : 0.0f};
          pg8::gemm_phase<pg8::EpiResid, pg8::StaticOrder, true, true>(lds, g, S, E); }
        GSYNC();
        for (int rep = 0; rep < NREP(0); ++rep) { pg8::Gemm g{XB, W + WO_GU2 + l * W_GU, T, 2 * FF, D}; pg8::StaticOrder S; S.init(T, 2 * FF, G, bx);
          pg8::EpiSwiglu E{R1, FF, ssl + 3 * TS16};
          pg8::gemm_phase<pg8::EpiSwiglu, pg8::StaticOrder, true, true>(lds, g, S, E); }
        GSYNC();
        for (int rep = 0; rep < NREP(1); ++rep) { const bool fin = rep == NREP(1) - 1; pg8::Gemm g{R1, W + WO_DN2 + l * W_DN, T, D, FF}; pg8::StaticOrder S; S.init(T, D, G, bx);
          pg8::EpiResid E{nullptr, XB, fin ? ssl + 4 * TS16 : SS + 9 * TS16, fin ? 0.5f : 0.0f};
          pg8::gemm_phase<pg8::EpiResid, pg8::StaticOrder, true, true>(lds, g, S, E); }
        GSYNC();
}

__global__ void __launch_bounds__(NWAVES * 64, 2) mk_fwd(Args args) {
    extern __shared__ __attribute__((aligned(16))) unsigned char lds_raw[];
    cg::grid_group grid = cg::this_grid();
    LAS unsigned char* lds = (LAS unsigned char*)lds_raw;
    const int tid = threadIdx.x, lane = tid & 63, wave = __builtin_amdgcn_readfirstlane(tid >> 6);
    const int G = gridDim.x, bx = blockIdx.x;
    const int gw = bx * NWAVES + wave, NGW = G * NWAVES;
    unsigned char* ws = args.ws;
    float* KSUM = (float*)(ws + WS_KSUM); float* SS = (float*)(ws + WS_SS);
    bf16* W = (bf16*)(ws + WS_W); bf16* MEMN = (bf16*)(ws + WS_MEMN); bf16* XKP = (bf16*)(ws + WS_XKP); bf16* XVP = (bf16*)(ws + WS_XVP);
    bf16* XB = (bf16*)(ws + WS_XB);
    const float* x_in = args.in[0]; float* OUT = args.out;
    if (tid < 2) ((LAS unsigned*)(lds + LDS_BARST_OFF))[tid] = 0u;
    __syncthreads();
    const XcdBarrier bar = xcd_barrier_post((unsigned*)(ws + WS_BAR), (volatile LAS unsigned*)(lds + LDS_BARST_OFF));

    for (int prep = 0; prep < NREP(10); ++prep) {
        LAS float* scr = (LAS float*)(lds + wave * 16384);
        for (int it = gw; it < N_JOB_ITEMS; it += NGW) {
            int r = it, j = 0; Job jb;
            for (;;) { jb = get_job(j, args, W); const int cnt = (jb.K / 64) * (jb.N / 32); if (r < cnt || j >= 21) break; r -= cnt; ++j; }
            transpose_item(jb, scr, r, lane);
        }
        for (int m0 = gw; m0 < T; m0 += 4 * NGW) {
            f32x4 v[4][4];
#pragma unroll
            for (int k = 0; k < 4; ++k) { const int m = m0 + k * NGW; if (m < T) { const f32x4* xr = (const f32x4*)(x_in + (size_t)m * D) + lane;
#pragma unroll
                for (int j = 0; j < 4; ++j) v[k][j] = xr[64 * j]; } }
#pragma unroll
            for (int k = 0; k < 4; ++k) { const int m = m0 + k * NGW; if (m < T) { float s = 0.f;
#pragma unroll
                for (int j = 0; j < 4; ++j) s += (v[k][j].x * v[k][j].x + v[k][j].y * v[k][j].y) + (v[k][j].z * v[k][j].z + v[k][j].w * v[k][j].w);
                s = wave_sum(s);
                v2u* o8 = (v2u*)(XB + (size_t)m * D) + lane;
#pragma unroll
                for (int j = 0; j < 4; ++j) { v2u o; o.x = pk2(v[k][j].x, v[k][j].y); o.y = pk2(v[k][j].z, v[k][j].w); o8[64 * j] = o; }
                if (lane == 0) ((unsigned long long*)SS)[m] = (unsigned long long)(s * 4294967296.0f); } }
        }
        for (int m = gw; m < MEMROWS; m += NGW) {
            const f32x4* xr = (const f32x4*)(args.in[1] + (size_t)m * D) + lane; const f32x4* gr = (const f32x4*)(args.in[18]) + lane; float s = 0.f; f32x4 v[4];
#pragma unroll
            for (int j = 0; j < 4; ++j) { v[j] = xr[64 * j]; s += (v[j].x * v[j].x + v[j].y * v[j].y) + (v[j].z * v[j].z + v[j].w * v[j].w); }
            s = wave_sum(s); const float rs = 1.0f / sqrtf(s * (1.0f / D) + 1e-6f);
            v2u* o8 = (v2u*)(MEMN + (size_t)m * D) + lane;
#pragma unroll
            for (int j = 0; j < 4; ++j) { const f32x4 g = gr[64 * j]; v2u o; o.x = pk2(v[j].x * rs * g.x, v[j].y * rs * g.y); o.y = pk2(v[j].z * rs * g.z, v[j].w * rs * g.w); o8[64 * j] = o; }
        }
        for (int i = bx * 512 + tid; i < 9 * T; i += G * 512) ((unsigned long long*)SS)[T + i] = 0ull;
        for (int i = bx * 512 + tid; i < NBATCH * 4 * 16 * 128; i += G * 512) ((unsigned long long*)KSUM)[i] = 0ull;
        build_bias_table(lds, args.in[13], true);
    }
    if (args.ws == nullptr) grid.sync();
    xcd_barrier(bar);

    layer_body<0>(args, lds, bar);
    layer_body<1>(args, lds, bar);
    int tidf_ = threadIdx.x; asm volatile("" : "+v"(tidf_)); const int lanef = tidf_ & 63, gwf = bx * NWAVES + __builtin_amdgcn_readfirstlane(tidf_ >> 6);
    for (int m0 = gwf; m0 < T; m0 += 4 * NGW) {
        const f32x4* gr = (const f32x4*)(args.in[23]) + lanef; v2u w[4][4];
#pragma unroll
        for (int k = 0; k < 4; ++k) { const int m = m0 + k * NGW; if (m < T) { const v2u* xr = (const v2u*)(XB + (size_t)m * D) + lanef;
#pragma unroll
            for (int j = 0; j < 4; ++j) w[k][j] = xr[64 * j]; } }
#pragma unroll
        for (int k = 0; k < 4; ++k) { const int m = m0 + k * NGW; if (m < T) { f32x4* orow = (f32x4*)(OUT + (size_t)m * D) + lanef; float s = 0.f; f32x4 v[4];
#pragma unroll
            for (int j = 0; j < 4; ++j) { v[j] = (f32x4){bflo(w[k][j].x), bfhi(w[k][j].x), bflo(w[k][j].y), bfhi(w[k][j].y)}; s += (v[j].x * v[j].x + v[j].y * v[j].y) + (v[j].z * v[j].z + v[j].w * v[j].w); }
            s = wave_sum(s); const float rs = 1.0f / sqrtf(s * (1.0f / D) + 1e-6f);
#pragma unroll
            for (int j = 0; j < 4; ++j) { const f32x4 g = gr[64 * j]; orow[64 * j] = (f32x4){v[j].x * rs * g.x, v[j].y * rs * g.y, v[j].z * rs * g.z, v[j].w * rs * g.w}; } } }
    }
}

extern "C" void kernel_launch(void* const* d_in, const int* in_sizes, int n_in, void* d_out, int out_size, void* d_ws, size_t ws_size, hipStream_t stream) {
    static int grid = 0;
    if (grid == 0) {
        if (n_in != 24 || in_sizes[0] != T * D || out_size != T * D || ws_size < WS_END) { fprintf(stderr, "kernel_launch: unexpected shapes (n_in %d, in0 %d, out %d, ws %zu)\n", n_in, n_in > 0 ? in_sizes[0] : -1, out_size, ws_size); grid = -1; return; }
        int dev = 0, cus = 0, per_cu = 0;
        (void)hipGetDevice(&dev); (void)hipDeviceGetAttribute(&cus, hipDeviceAttributeMultiprocessorCount, dev);
        if (hipFuncSetAttribute((const void*)mk_fwd, hipFuncAttributeMaxDynamicSharedMemorySize, LDS_BYTES) != hipSuccess) { fprintf(stderr, "kernel_launch: hipFuncSetAttribute failed\n"); grid = -1; return; }
        if (hipOccupancyMaxActiveBlocksPerMultiprocessor(&per_cu, (const void*)mk_fwd, NWAVES * 64, LDS_BYTES) != hipSuccess || per_cu < 1) { fprintf(stderr, "kernel_launch: occupancy query says %d\n", per_cu); per_cu = 1; }
        (void)hipGetLastError();
        grid = cus;
        if (grid <= 0) grid = 256;
    }
    if (grid < 0) return;
    if (hipMemsetAsync((char*)d_ws + WS_BAR, 0, XCD_BAR_WORDS * 4, stream) != hipSuccess) { fprintf(stderr, "kernel_launch: memset failed\n"); return; }
    Args a{};
    for (int i = 0; i < 24; ++i) a.in[i] = (const float*)d_in[i];
    a.out = (float*)d_out; a.ws = (unsigned char*)d_ws;
    void* kargs[] = {&a};
    hipError_t e = hipLaunchCooperativeKernel((const void*)mk_fwd, dim3(grid), dim3(NWAVES * 64), kargs, LDS_BYTES, stream);
    if (e != hipSuccess) fprintf(stderr, "kernel_launch: cooperative launch failed: %s (grid %d)\n", hipGetErrorString(e), grid);
}
```

```cpp
#include <hip/hip_runtime.h>
#include <hip/hip_cooperative_groups.h>
#include <cstdio>
#include <cstdint>
namespace cg = cooperative_groups;
namespace pg8 {
#define PG8_LAS __attribute__((address_space(3)))
typedef unsigned short bf16_t;
typedef short bf16x8 __attribute__((ext_vector_type(8)));
typedef float f32x4 __attribute__((ext_vector_type(4)));
typedef unsigned u32x4 __attribute__((ext_vector_type(4)));
constexpr int BM = 256, BK = 64, HALF = 128, HTB = HALF * BK * 2  , STAGE_BYTES = 8 * HTB, NXCD = 8, WGM = 8;

__host__ __device__ __forceinline__ int lds_byte(int r, int c) { const int st = (r >> 4) * 2 + (c >> 5), rr = r & 15, cc = c & 31, ob = rr * 64 + cc * 2; return st * 1024 + (ob ^ (((ob >> 9) & 1) << 5)); }
__host__ __device__ __forceinline__ void stage_rc(int b, int& R, int& C) { const int st = b / 1024, sb = b % 1024, swz = sb ^ (((sb >> 9) & 1) << 5); R = (st >> 1) * 16 + swz / 64; C = (st & 1) * 32 + (swz % 64) / 2; }
__host__ __device__ __forceinline__ int perm32(int rho) { const int n = rho >> 4, i = rho & 15; return 8 * (i >> 2) + 4 * n + (i & 3); }

struct Unit { int pm, pn; };
struct Gemm { const bf16_t* A; const bf16_t* Bt; int M, N, K; };

struct StaticOrder {
    int nM, nN, nwg, G, c;
    __host__ __device__ void init(int M, int N, int G_, int c_) { nM = M / BM; nN = N / BM; nwg = nM * nN; G = G_; c = c_; }
    __host__ __device__ bool next(int i, Unit& u) const {
        const long L = (long)i * G + c; if (L >= nwg) return false;
        int wgid = (int)L; { const int q = nwg / NXCD, r = nwg % NXCD, xcd = wgid % NXCD, off = wgid / NXCD; wgid = (xcd < r ? xcd * (q + 1) : r * (q + 1) + (xcd - r) * q) + off; }
        const int nig = WGM * nN, gid = wgid / nig, fm = gid * WGM, gsz = (nM - fm) < WGM ? (nM - fm) : WGM;
        u.pm = fm + ((wgid % nig) % gsz); u.pn = (wgid % nig) / gsz; return true;
    }
    __device__ __forceinline__ void a_ready(const Unit&) const {}
    __device__ __forceinline__ void done(const Unit&) const {}
};

__device__ __forceinline__ unsigned cvt_pk_bf16(float lo, float hi) { unsigned r; asm volatile("v_cvt_pk_bf16_f32 %0, %1, %2" : "=v"(r) : "v"(lo), "v"(hi)); return r; }
constexpr float RMS_EPS = 1e-6f;
__device__ __forceinline__ float row_rs(const float* ssp, int row) { const unsigned long long v = ((const unsigned long long*)ssp)[row];
    return __builtin_amdgcn_rsqf((float)v * (1.0f / 4294967296.0f) * (1.0f / 1024.0f) + RMS_EPS); }
__device__ __forceinline__ void fx_add(float* p, size_t idx, float s) { atomicAdd((unsigned long long*)p + idx, (unsigned long long)(long long)(s * 4294967296.0f)); }
typedef float f32x2v_ __attribute__((ext_vector_type(2))); typedef __bf16 bf16x2v_ __attribute__((ext_vector_type(2)));
__device__ __forceinline__ unsigned cvtpk(float lo, float hi) { f32x2v_ v = {lo, hi}; bf16x2v_ b = __builtin_convertvector(v, bf16x2v_); return __builtin_bit_cast(unsigned, b); }
struct EpiSwiglu {
    static constexpr bool PERM = true, AFTER_DRAIN = false;
    bf16_t* H; int ldh; const float* ss;
    __device__ __forceinline__ void operator()(const f32x4 (&acc)[2][2][4][2], const Unit& u, int wr, int wc, int fr, int fq) const {
        const int row0 = u.pm * BM + wr * 64 + fr, col0 = u.pn * HALF + wc * 32 + 8 * fq;
#pragma unroll
        for (int ai = 0; ai < 2; ++ai)
#pragma unroll
            for (int m = 0; m < 4; ++m) { const int row = row0 + ai * HALF + m * 16; const float rs = row_rs(ss, row);
                float hv[8];
#pragma unroll
                for (int n = 0; n < 2; ++n)
#pragma unroll
                    for (int i = 0; i < 4; ++i) { const float g = acc[ai][0][m][n][i] * rs, uu = acc[ai][1][m][n][i] * rs;
                        hv[n * 4 + i] = g * __builtin_amdgcn_rcpf(1.0f + __expf(-g)) * uu; }
                u32x4 w; w.x = cvtpk(hv[0], hv[1]); w.y = cvtpk(hv[2], hv[3]); w.z = cvtpk(hv[4], hv[5]); w.w = cvtpk(hv[6], hv[7]);
                *(u32x4*)(H + (size_t)row * ldh + col0) = w; }
    }
};
struct EpiScaleBf16 {
    static constexpr bool PERM = true, AFTER_DRAIN = false;
    bf16_t* O; int ldc; const float* ss;
    __device__ __forceinline__ void operator()(const f32x4 (&acc)[2][2][4][2], const Unit& u, int wr, int wc, int fr, int fq) const {
        const int row0 = u.pm * BM + wr * 64 + fr, col0 = u.pn * BM + wc * 32 + 8 * fq;
#pragma unroll
        for (int ai = 0; ai < 2; ++ai)
#pragma unroll
            for (int m = 0; m < 4; ++m) { const int row = row0 + ai * HALF + m * 16; const float rs = ss ? row_rs(ss, row) : 1.0f;
#pragma unroll
                for (int bj = 0; bj < 2; ++bj) { const f32x4 v0 = acc[ai][bj][m][0] * rs, v1 = acc[ai][bj][m][1] * rs;
                    u32x4 w; w.x = cvtpk(v0[0], v0[1]); w.y = cvtpk(v0[2], v0[3]); w.z = cvtpk(v1[0], v1[1]); w.w = cvtpk(v1[2], v1[3]);
                    *(u32x4*)(O + (size_t)row * ldc + col0 + bj * HALF) = w; } }
    }
};
struct EpiResid {
    static constexpr bool PERM = true, AFTER_DRAIN = false;
    const float* xin32; bf16_t* xb; float* ssout; float alpha;
    __device__ __forceinline__ void operator()(const f32x4 (&acc)[2][2][4][2], const Unit& u, int wr, int wc, int fr, int fq) const {
        const int row0 = u.pm * BM + wr * 64 + fr, col0 = u.pn * BM + wc * 32 + 8 * fq;
#pragma unroll
        for (int ai = 0; ai < 2; ++ai)
#pragma unroll
            for (int m = 0; m < 4; ++m) { const int row = row0 + ai * HALF + m * 16; const size_t off = (size_t)row * 1024 + col0; float s = 0.f;
#pragma unroll
                for (int bj = 0; bj < 2; ++bj) { f32x4 a0, a1;
                    if (xin32) { const float* p = xin32 + off + bj * HALF; a0 = *(const f32x4*)p; a1 = *(const f32x4*)(p + 4); }
                    else { const u32x4 w = *(const u32x4*)(xb + off + bj * HALF);
                        a0 = (f32x4){__uint_as_float(w.x << 16), __uint_as_float(w.x & 0xffff0000u), __uint_as_float(w.y << 16), __uint_as_float(w.y & 0xffff0000u)};
                        a1 = (f32x4){__uint_as_float(w.z << 16), __uint_as_float(w.z & 0xffff0000u), __uint_as_float(w.w << 16), __uint_as_float(w.w & 0xffff0000u)}; }
                    const f32x4 v0 = a0 + acc[ai][bj][m][0] * alpha, v1 = a1 + acc[ai][bj][m][1] * alpha;
                    u32x4 w; w.x = cvtpk(v0[0], v0[1]); w.y = cvtpk(v0[2], v0[3]); w.z = cvtpk(v1[0], v1[1]); w.w = cvtpk(v1[2], v1[3]);
                    *(u32x4*)(xb + off + bj * HALF) = w;
                    s += (v0[0] * v0[0] + v0[1] * v0[1]) + (v0[2] * v0[2] + v0[3] * v0[3]) + (v1[0] * v1[0] + v1[1] * v1[1]) + (v1[2] * v1[2] + v1[3] * v1[3]); }
                s += __shfl_xor(s, 16); s += __shfl_xor(s, 32);
                if (fq == 0) fx_add(ssout, row, s); }
    }
};
struct EpiQKV {
    static constexpr bool PERM = true, AFTER_DRAIN = false;
    bf16_t* O; int ldc; const float* ss; bf16_t* KP; bf16_t* VP; int kbeg, vbeg, dh_shift, kvh, S_shift; float* ksum;
    __device__ __forceinline__ void operator()(const f32x4 (&acc)[2][2][4][2], const Unit& u, int wr, int wc, int fr, int fq) const {
        const int row0 = u.pm * BM + wr * 64 + fr; const int DH = 1 << dh_shift;
#pragma unroll
        for (int bj = 0; bj < 2; ++bj) {
            const int cbase = u.pn * BM + bj * HALF, c0 = cbase + wc * 32 + 8 * fq;
            if (cbase < kbeg) {
#pragma unroll
                for (int ai = 0; ai < 2; ++ai)
#pragma unroll
                    for (int m = 0; m < 4; ++m) { const int row = row0 + ai * HALF + m * 16; const float rs = ss ? row_rs(ss, row) : 1.0f;
                        const f32x4 v0 = acc[ai][bj][m][0] * rs, v1 = acc[ai][bj][m][1] * rs;
                        u32x4 w; w.x = cvtpk(v0[0], v0[1]); w.y = cvtpk(v0[2], v0[3]); w.z = cvtpk(v1[0], v1[1]); w.w = cvtpk(v1[2], v1[3]);
                        *(u32x4*)(O + (size_t)row * ldc + c0) = w; }
            } else if (cbase < vbeg) {
                const int c = c0 - kbeg, head = c >> dh_shift, d = c & (DH - 1);
                float cs[8];
#pragma unroll
                for (int e = 0; e < 8; ++e) cs[e] = 0.f;
#pragma unroll
                for (int ai = 0; ai < 2; ++ai)
#pragma unroll
                    for (int m = 0; m < 4; ++m) { const int row = row0 + ai * HALF + m * 16; const float rs = ss ? row_rs(ss, row) : 1.0f;
                        const f32x4 v0 = acc[ai][bj][m][0] * rs, v1 = acc[ai][bj][m][1] * rs;
                        const int b = row >> S_shift, pos = row & ((1 << S_shift) - 1);
                        const size_t tile = ((size_t)(b * kvh + head) << (S_shift - 5)) + (pos >> 5);
                        u32x4 w; w.x = cvtpk(v0[0], v0[1]); w.y = cvtpk(v0[2], v0[3]); w.z = cvtpk(v1[0], v1[1]); w.w = cvtpk(v1[2], v1[3]);
                        *(u32x4*)(KP + tile * (size_t)(32 * DH) + ((d >> 3) * 32 + (pos & 31)) * 8) = w;
#pragma unroll
                        for (int e = 0; e < 4; ++e) { cs[e] += v0[e]; cs[4 + e] += v1[e]; } }
                if (ksum) {
#pragma unroll
                    for (int e = 0; e < 8; ++e) { float s = cs[e]; s += __shfl_xor(s, 1); s += __shfl_xor(s, 2); s += __shfl_xor(s, 4); s += __shfl_xor(s, 8); cs[e] = s; }
                    if (fr == 0) { const int rowb = u.pm * BM; const int b = rowb >> S_shift, blk = (rowb & ((1 << S_shift) - 1)) >> 8;
                        const size_t kd = ((size_t)((b * kvh + head) << (S_shift - 8)) + blk) * DH + d;
#pragma unroll
                        for (int e = 0; e < 8; ++e) fx_add(ksum, kd + e, cs[e]); }
                }
            } else {
                const int c = c0 - vbeg, head = c >> dh_shift, d = c & (DH - 1);
#pragma unroll
                for (int ai = 0; ai < 2; ++ai)
#pragma unroll
                    for (int m = 0; m < 4; ++m) { const int row = row0 + ai * HALF + m * 16; const float rs = ss ? row_rs(ss, row) : 1.0f;
                        const f32x4 v0 = acc[ai][bj][m][0] * rs, v1 = acc[ai][bj][m][1] * rs;
                        const int b = row >> S_shift, pos = row & ((1 << S_shift) - 1);
                        const size_t tile = ((size_t)(b * kvh + head) << (S_shift - 5)) + (pos >> 5);
                        bf16_t* vp = VP + tile * (size_t)(32 * DH) + ((((pos & 31) >> 3) << dh_shift) + d) * 8 + (pos & 7);
                        const unsigned w0 = cvtpk(v0[0], v0[1]), w1 = cvtpk(v0[2], v0[3]), w2 = cvtpk(v1[0], v1[1]), w3 = cvtpk(v1[2], v1[3]);
                        vp[0] = (bf16_t)(w0 & 0xffffu); vp[8] = (bf16_t)(w0 >> 16); vp[16] = (bf16_t)(w1 & 0xffffu); vp[24] = (bf16_t)(w1 >> 16);
                        vp[32] = (bf16_t)(w2 & 0xffffu); vp[40] = (bf16_t)(w2 >> 16); vp[48] = (bf16_t)(w3 & 0xffffu); vp[56] = (bf16_t)(w3 >> 16); }
            }
        }
    }
};
template <class Epi, class Sched, bool ALIGN_EPI = false, bool SP2 = false>
__device__ __forceinline__ void gemm_phase(PG8_LAS unsigned char* lds, const Gemm g, const Sched& S, const Epi& E) {
    int tid_ = threadIdx.x; asm volatile("" : "+v"(tid_));
    const int tid = tid_, wid = __builtin_amdgcn_readfirstlane(tid >> 6), lane = tid & 63, wr = wid >> 2, wc = wid & 3, fr = lane & 15, fq = lane >> 4;
    const int K = g.K, nt = K / BK;
    unsigned voffA[2], voffB[2];
#pragma unroll
    for (int i = 0; i < 2; ++i) { int R, C; stage_rc(tid * 16 + i * 8192, R, C); const int Rb = Epi::PERM ? ((R & ~31) + perm32(R & 31)) : R;
        voffA[i] = (unsigned)(R * K + C) * 2u; voffB[i] = (unsigned)(Rb * K + C) * 2u; }
    const size_t kstep = (size_t)(BK * 2);
    const size_t hstep = (size_t)HALF * K * 2;
    const size_t tstep = 2 * hstep;
    const unsigned ldsw = (unsigned)wid * 1024u;
    const int aoff = lds_byte(wr * 64 + fr, fq * 8), boff = lds_byte(wc * 32 + fr, fq * 8);
#define PG8_SA(b, h) (((b) * 2 + (h)) * HTB)
#define PG8_SB(b, h) ((4 + (b) * 2 + (h)) * HTB)
#define PG8_STAGE(bufoff, gbase, voff) do { _Pragma("unroll") for (int _i = 0; _i < 2; ++_i) \
        __builtin_amdgcn_global_load_lds((const unsigned*)((const char*)(gbase) + (voff)[_i]), (PG8_LAS unsigned*)(lds + (bufoff) + ldsw + _i * 8192), 16, 0, 0); } while (0)
#define PG8_LDA(dst, b, h) do { _Pragma("unroll") for (int m = 0; m < 4; ++m) _Pragma("unroll") for (int k = 0; k < 2; ++k) dst[m][k] = *(const PG8_LAS bf16x8*)(lds + PG8_SA(b, h) + aoff + m * 2048 + k * 1024); } while (0)
#define PG8_LDB(dst, b, h) do { _Pragma("unroll") for (int n = 0; n < 2; ++n) _Pragma("unroll") for (int k = 0; k < 2; ++k) dst[n][k] = *(const PG8_LAS bf16x8*)(lds + PG8_SB(b, h) + boff + n * 2048 + k * 1024); } while (0)
#define PG8_MMA(ai, bj, At, Bt) do { __builtin_amdgcn_s_setprio(1); _Pragma("unroll") for (int m = 0; m < 4; ++m) _Pragma("unroll") for (int n = 0; n < 2; ++n) _Pragma("unroll") for (int k = 0; k < 2; ++k) \
        acc[ai][bj][m][n] = __builtin_amdgcn_mfma_f32_16x16x32_bf16(Bt[n][k], At[m][k], acc[ai][bj][m][n], 0, 0, 0); __builtin_amdgcn_s_setprio(0); } while (0)
#define PG8_WAIT_V(n) asm volatile("s_waitcnt vmcnt(" #n ")" ::: "memory")
#define PG8_WAIT_L(n) asm volatile("s_waitcnt lgkmcnt(" #n ")" ::: "memory")
#define PG8_BAR __builtin_amdgcn_s_barrier()
#define PG8_SCHED __builtin_amdgcn_sched_barrier(0)
    Unit cur, nxt; int ui = 0;
    if (!S.next(0, cur)) return;
    f32x4 acc[2][2][4][2];
#pragma unroll
    for (int a = 0; a < 2; ++a)
#pragma unroll
        for (int b = 0; b < 2; ++b)
#pragma unroll
            for (int m = 0; m < 4; ++m)
#pragma unroll
                for (int n = 0; n < 2; ++n) acc[a][b][m][n] = (f32x4){0.f, 0.f, 0.f, 0.f};
    bf16x8 At[4][2], B0[2][2], B1[2][2];
    const char* cA = (const char*)g.A + (size_t)cur.pm * tstep; const char* cB = (const char*)g.Bt + (size_t)cur.pn * tstep;
    S.a_ready(cur);
    if constexpr (SP2) {
        PG8_STAGE(PG8_SB(0, 0), cB, voffB); PG8_STAGE(PG8_SB(0, 1), cB + hstep, voffB); PG8_STAGE(PG8_SA(0, 0), cA, voffA); PG8_STAGE(PG8_SA(0, 1), cA + hstep, voffA);
        if (wr == 1) PG8_BAR;
        PG8_WAIT_V(2); PG8_BAR;
        PG8_STAGE(PG8_SB(1, 0), cB + kstep, voffB); PG8_STAGE(PG8_SA(1, 0), cA + kstep, voffA); PG8_STAGE(PG8_SB(1, 1), cB + hstep + kstep, voffB);
        PG8_WAIT_V(6); PG8_BAR;
    } else {
        PG8_STAGE(PG8_SB(0, 0), cB, voffB); PG8_STAGE(PG8_SA(0, 0), cA, voffA); PG8_STAGE(PG8_SB(0, 1), cB + hstep, voffB); PG8_STAGE(PG8_SA(0, 1), cA + hstep, voffA);
        if (wr == 1) PG8_BAR;
        PG8_WAIT_V(4); PG8_BAR;
        PG8_STAGE(PG8_SB(1, 0), cB + kstep, voffB); PG8_STAGE(PG8_SA(1, 0), cA + kstep, voffA); PG8_STAGE(PG8_SB(1, 1), cB + hstep + kstep, voffB);
        PG8_WAIT_V(6); PG8_BAR;
    }
    for (;;) {
        const bool has_next = S.next(ui + 1, nxt);
        const char* nA = has_next ? (const char*)g.A + (size_t)nxt.pm * tstep : cA; const char* nB = has_next ? (const char*)g.Bt + (size_t)nxt.pn * tstep : cB;
        for (int t = 0; t < nt; t += 2) {
            const bool last = (t == nt - 2);
            const char* a1 = cA + (size_t)(t + 1) * kstep;
            const char* a2 = last ? nA : cA + (size_t)(t + 2) * kstep; const char* b2 = last ? nB : cB + (size_t)(t + 2) * kstep;
            const char* a3 = a2 + kstep; const char* b3 = b2 + kstep;
            if (last && has_next) S.a_ready(nxt);
            if constexpr (SP2) {
            PG8_LDB(B0, 0, 0); PG8_LDB(B1, 0, 1); PG8_SCHED; PG8_LDA(At, 0, 0); PG8_STAGE(PG8_SA(1, 1), a1 + hstep, voffA);
            PG8_WAIT_V(8); PG8_WAIT_L(0); PG8_BAR; PG8_MMA(0, 0, At, B0); PG8_MMA(0, 1, At, B1); PG8_BAR; PG8_SCHED;
            PG8_LDA(At, 0, 1); PG8_STAGE(PG8_SB(0, 0), b2, voffB); PG8_STAGE(PG8_SB(0, 1), b2 + hstep, voffB); PG8_STAGE(PG8_SA(0, 0), a2, voffA);
            PG8_WAIT_V(8); PG8_WAIT_L(0); PG8_BAR; PG8_MMA(1, 0, At, B0); PG8_MMA(1, 1, At, B1); PG8_BAR; PG8_SCHED;
            PG8_LDB(B0, 1, 0); PG8_LDB(B1, 1, 1); PG8_SCHED; PG8_LDA(At, 1, 0); PG8_STAGE(PG8_SA(0, 1), a2 + hstep, voffA);
            PG8_WAIT_V(8); PG8_WAIT_L(0); PG8_BAR; PG8_MMA(0, 0, At, B0); PG8_MMA(0, 1, At, B1); PG8_BAR; PG8_SCHED;
            PG8_LDA(At, 1, 1); PG8_STAGE(PG8_SB(1, 0), b3, voffB); PG8_STAGE(PG8_SB(1, 1), b3 + hstep, voffB); PG8_STAGE(PG8_SA(1, 0), a3, voffA);
            PG8_WAIT_V(8); PG8_WAIT_L(0); PG8_BAR; PG8_MMA(1, 0, At, B0); PG8_MMA(1, 1, At, B1); PG8_BAR; PG8_SCHED;
            } else {
            PG8_LDB(B0, 0, 0); PG8_SCHED; PG8_LDA(At, 0, 0); PG8_STAGE(PG8_SA(1, 1), a1 + hstep, voffA);
            PG8_WAIT_L(8); PG8_BAR; PG8_WAIT_L(0); PG8_MMA(0, 0, At, B0); PG8_BAR; PG8_SCHED;
            PG8_LDB(B1, 0, 1); PG8_STAGE(PG8_SB(0, 0), b2, voffB);
            PG8_BAR; PG8_WAIT_L(0); PG8_MMA(0, 1, At, B1); PG8_BAR;
            PG8_LDA(At, 0, 1); PG8_STAGE(PG8_SA(0, 0), a2, voffA);
            PG8_BAR; PG8_WAIT_L(0); PG8_MMA(1, 0, At, B0); PG8_BAR; PG8_SCHED;
            PG8_STAGE(PG8_SB(0, 1), b2 + hstep, voffB);
            PG8_WAIT_V(6); PG8_BAR; PG8_MMA(1, 1, At, B1); PG8_BAR;
            PG8_LDB(B0, 1, 0); PG8_SCHED; PG8_LDA(At, 1, 0); PG8_STAGE(PG8_SA(0, 1), a2 + hstep, voffA);
            PG8_WAIT_L(8); PG8_BAR; PG8_WAIT_L(0); PG8_MMA(0, 0, At, B0); PG8_BAR; PG8_SCHED;
            PG8_LDB(B1, 1, 1); PG8_STAGE(PG8_SB(1, 0), b3, voffB);
            PG8_BAR; PG8_WAIT_L(0); PG8_MMA(0, 1, At, B1); PG8_BAR;
            PG8_LDA(At, 1, 1); PG8_STAGE(PG8_SA(1, 0), a3, voffA);
            PG8_BAR; PG8_WAIT_L(0); PG8_MMA(1, 0, At, B0); PG8_BAR; PG8_SCHED;
            PG8_STAGE(PG8_SB(1, 1), b3 + hstep, voffB);
            PG8_WAIT_V(6); PG8_BAR; PG8_MMA(1, 1, At, B1); PG8_BAR;
            }
        }
        if constexpr (ALIGN_EPI) { if (wr == 0) PG8_BAR; }
        if constexpr (!Epi::AFTER_DRAIN) { E(acc, cur, wr, wc, fr, fq); S.done(cur); }
        if (!has_next) break;
#pragma unroll
        for (int a = 0; a < 2; ++a)
#pragma unroll
            for (int b = 0; b < 2; ++b)
#pragma unroll
                for (int m = 0; m < 4; ++m)
#pragma unroll
                    for (int n = 0; n < 2; ++n) acc[a][b][m][n] = (f32x4){0.f, 0.f, 0.f, 0.f};
        cur = nxt; cA = nA; cB = nB; ++ui;
        if constexpr (ALIGN_EPI) { if (wr == 1) PG8_BAR; }
    }
    PG8_WAIT_V(0);
    if constexpr (!ALIGN_EPI) { if (wr == 0) PG8_BAR; }
    PG8_BAR;
    if constexpr (Epi::AFTER_DRAIN) { E.fused(acc, cur, wr, wc, fr, fq, lds, wid, lane); S.done(cur); }
#undef PG8_SA
#undef PG8_SB
#undef PG8_STAGE
#undef PG8_LDA
#undef PG8_LDB
#undef PG8_MMA
#undef PG8_WAIT_V
#undef PG8_WAIT_L
#undef PG8_BAR
#undef PG8_SCHED
}
}
#ifndef DUPMASK
#define DUPMASK 0
#endif
#define NREP(k) (1 + ((DUPMASK >> (k)) & 1))
#define GSYNC() do { for (int rs_ = 0; rs_ < NREP(9); ++rs_) xcd_barrier(bar); } while (0)
constexpr int NWAVES = 8;
constexpr int T = 32768, D = 1024, FF = 2816, SEQ = 4096, NBATCH = 8, MEMLEN = 256, MEMROWS = NBATCH * MEMLEN;
constexpr int EV_IN = 2304, OD_IN = 2048, XAW = 512;
#define GAS __attribute__((address_space(1)))
#define LAS __attribute__((address_space(3)))
typedef unsigned short bf16;
typedef unsigned v4u __attribute__((ext_vector_type(4)));
typedef unsigned v2u __attribute__((ext_vector_type(2)));
typedef float f32x4 __attribute__((ext_vector_type(4)));
#define LDS_WAIT() asm volatile("s_waitcnt lgkmcnt(0)" ::: "memory")
__device__ __forceinline__ unsigned f2bf(float f) { unsigned u = __builtin_bit_cast(unsigned, f); return (u + 0x7fffu + ((u >> 16) & 1u)) >> 16; }
__device__ __forceinline__ unsigned pk2(float lo, float hi) { return f2bf(lo) | (f2bf(hi) << 16); }
__device__ __forceinline__ float bflo(unsigned w) { return __uint_as_float(w << 16); }
__device__ __forceinline__ float bfhi(unsigned w) { return __uint_as_float(w & 0xffff0000u); }
__device__ __forceinline__ float bf1(bf16 b) { return __uint_as_float((unsigned)b << 16); }
__device__ __forceinline__ float wave_sum(float v) {
#pragma unroll
    for (int o = 1; o < 64; o <<= 1) v += __shfl_xor(v, o);
    return v;
}
__device__ __forceinline__ int rel_bucket(int n) {
    if (n < 16) return n;
    int b = 16;
    b += (n >= 19); b += (n >= 21); b += (n >= 24); b += (n >= 27); b += (n >= 31); b += (n >= 35); b += (n >= 40); b += (n >= 46);
    b += (n >= 52); b += (n >= 59); b += (n >= 67); b += (n >= 77); b += (n >= 87); b += (n >= 99); b += (n >= 113);
    return b;
}

constexpr size_t MiB = 1u << 20;
constexpr size_t WS_TAB = 0;
constexpr int TABW = 256, TPAD = 32;
constexpr size_t WS_KSUM = 64 * 1024;
constexpr size_t WS_BAR = 16 * 1024;
constexpr size_t WS_SS = 448 * MiB;
constexpr size_t WS_W = 4 * MiB;
constexpr size_t W_GU = (size_t)2 * FF * D, W_DN = (size_t)D * FF;
constexpr size_t WO_GU1 = 0, WO_DN1 = WO_GU1 + 2 * W_GU, WO_GU2 = WO_DN1 + 2 * W_DN, WO_DN2 = WO_GU2 + 2 * W_GU;
constexpr size_t WO_EVIN = WO_DN2 + 2 * W_DN, WO_EVOUT = WO_EVIN + (size_t)EV_IN * D, WO_ODIN = WO_EVOUT + (size_t)D * D, WO_ODOUT = WO_ODIN + (size_t)OD_IN * D;
constexpr size_t WO_XQ = WO_ODOUT + (size_t)D * D, WO_XKV = WO_XQ + 2 * (size_t)XAW * D, WO_XO = WO_XKV + (size_t)2 * 1024 * D, WO_END = WO_XO + 2 * (size_t)D * XAW;
static_assert(WO_END * 2 <= 96 * MiB, "weights fit");
constexpr size_t WS_MEMN = 100 * MiB;
constexpr size_t WS_XKP = 104 * MiB, WS_XVP = 108 * MiB;
constexpr size_t WS_XB = 112 * MiB;
constexpr size_t WS_Y = 176 * MiB;
constexpr size_t WS_R1 = 240 * MiB;
constexpr size_t WS_XQ = WS_R1, WS_XO = WS_R1 + 32 * MiB;
constexpr size_t WS_KPAN = WS_R1 + 144 * MiB;
constexpr size_t WS_VPAN = WS_R1 + 176 * MiB;
constexpr size_t WS_END = WS_VPAN + 32 * MiB + 20 * MiB;
constexpr size_t WS_XDUMMY = WS_Y;

constexpr int LDS_BYTES = 147456, LDS_TAB_OFF = 131072, LDS_BARST_OFF = 131072 + 8192;

struct Args { const float* in[24]; float* out; unsigned char* ws; };

struct Job { const float* src; const float* gain; bf16* dst; int K, N, mode; };
__device__ __forceinline__ Job get_job(int j, const Args& a, bf16* W) {
    Job b; b.gain = nullptr; b.mode = 0;
    if (j < 18) { const int l = j / 9, r = j % 9;
        switch (r) {
        case 0: b.src = a.in[3] + (size_t)l * D * FF; b.gain = a.in[2] + l * D; b.dst = W + WO_GU1 + l * W_GU; b.K = D; b.N = FF; b.mode = 1; break;
        case 1: b.src = a.in[4] + (size_t)l * D * FF; b.gain = a.in[2] + l * D; b.dst = W + WO_GU1 + l * W_GU; b.K = D; b.N = FF; b.mode = 2; break;
        case 2: b.src = a.in[5] + (size_t)l * D * FF; b.dst = W + WO_DN1 + l * W_DN; b.K = FF; b.N = D; break;
        case 3: b.src = a.in[20] + (size_t)l * D * FF; b.gain = a.in[19] + l * D; b.dst = W + WO_GU2 + l * W_GU; b.K = D; b.N = FF; b.mode = 1; break;
        case 4: b.src = a.in[21] + (size_t)l * D * FF; b.gain = a.in[19] + l * D; b.dst = W + WO_GU2 + l * W_GU; b.K = D; b.N = FF; b.mode = 2; break;
        case 5: b.src = a.in[22] + (size_t)l * D * FF; b.dst = W + WO_DN2 + l * W_DN; b.K = FF; b.N = D; break;
        case 6: b.src = a.in[15] + (size_t)l * D * XAW; b.gain = a.in[14] + l * D; b.dst = W + WO_XQ + (size_t)l * XAW * D; b.K = D; b.N = XAW; break;
        case 7: b.src = a.in[16] + (size_t)l * D * 1024; b.dst = W + WO_XKV + (size_t)l * 1024 * D; b.K = D; b.N = 1024; break;
        default: b.src = a.in[17] + (size_t)l * XAW * D; b.dst = W + WO_XO + (size_t)l * D * XAW; b.K = XAW; b.N = D; break;
        }
    } else {
        switch (j) {
        case 18: b.src = a.in[7]; b.gain = a.in[6]; b.dst = W + WO_EVIN; b.K = D; b.N = EV_IN; break;
        case 19: b.src = a.in[10]; b.dst = W + WO_EVOUT; b.K = D; b.N = D; break;
        case 20: b.src = a.in[11]; b.gain = a.in[6] + D; b.dst = W + WO_ODIN; b.K = D; b.N = OD_IN; break;
        default: b.src = a.in[12]; b.dst = W + WO_ODOUT; b.K = D; b.N = D; break;
        }
    }
    return b;
}
__device__ __forceinline__ void transpose_item(const Job& jb, LAS float* scr, int item, int lane) {
    const int K = jb.K, N = jb.N; const int nblk = N / 32, kb = item / nblk, nb = item % nblk, k0 = 64 * kb, n0 = 32 * nb;
    int r0 = n0; if (jb.mode) r0 = 256 * (n0 / 128) + (n0 % 128) + (jb.mode == 2 ? 128 : 0);
#pragma unroll
    for (int i = 0; i < 8; ++i) { const int kk = 8 * i + (lane >> 3), c4 = 4 * (lane & 7); const float g = jb.gain ? jb.gain[k0 + kk] : 1.0f;
        const f32x4 v = *(const f32x4*)(jb.src + (size_t)(k0 + kk) * N + n0 + c4); LAS float* d = scr + kk * 33 + c4;
        d[0] = v.x * g; d[1] = v.y * g; d[2] = v.z * g; d[3] = v.w * g; }
    LDS_WAIT(); asm volatile("" ::: "memory");
    const int c = lane & 7;
#pragma unroll
    for (int j = 0; j < 4; ++j) { const int n = (lane >> 3) + 8 * j; const LAS float* s = scr + (8 * c) * 33 + n;
        v4u o; o.x = pk2(s[0 * 33], s[1 * 33]); o.y = pk2(s[2 * 33], s[3 * 33]); o.z = pk2(s[4 * 33], s[5 * 33]); o.w = pk2(s[6 * 33], s[7 * 33]);
        *(v4u*)(jb.dst + (size_t)(r0 + n) * K + k0 + 8 * c) = o; }
    LDS_WAIT(); asm volatile("" ::: "memory");
}
constexpr int N_JOB_ITEMS = 2 * (6 * 1408 + 256 + 512 + 256) + 1152 + 512 + 1024 + 512;


#define XB_TMO      128
#define XB_XCNT(j)  (256  + 64 * (j))
#define XB_XSUB(j)  (1280 + 64 * (j))
#define XB_XGEN(j)  (2304 + 64 * (j))
#define XB_TOP      3328
#define XB_TOPGEN   3392
#define XCD_BAR_WORDS 3456
#define XB_SPIN_CAP (1u << 18)

__device__ __forceinline__ unsigned xb_ld(unsigned* p)              { return __hip_atomic_load(p, __ATOMIC_RELAXED, __HIP_MEMORY_SCOPE_AGENT); }
__device__ __forceinline__ unsigned xb_add(unsigned* p, unsigned v) { return __hip_atomic_fetch_add(p, v, __ATOMIC_RELAXED, __HIP_MEMORY_SCOPE_AGENT); }
__device__ __forceinline__ unsigned xb_xcc_id() { return (unsigned)__builtin_amdgcn_s_getreg((3 << 11) | 20) & 0xFu; }
#define XB_SPIN(cond, bar) do { unsigned _sp = 0; while (cond) { __builtin_amdgcn_s_sleep(1); \
    if ((++_sp & 255u) == 0u) { if (xb_ld(&(bar)[XB_TMO])) break; if (_sp > XB_SPIN_CAP) { atomicAdd(&(bar)[XB_TMO], 1u); break; } } } } while (0)

struct XcdBarrier {
    unsigned* bar; unsigned x;
    volatile LAS unsigned* st;
};

__device__ __forceinline__ XcdBarrier xcd_barrier_post(unsigned* bar, volatile LAS unsigned* st) {
    XcdBarrier b; b.bar = bar; b.x = xb_xcc_id(); b.st = st;
    if (threadIdx.x == 0) (void)xb_add(&bar[XB_XCNT(b.x)], 1u);
    return b;
}
__device__ __forceinline__ void xcd_barrier_complete(unsigned* bar, unsigned x, unsigned& nloc, unsigned& nx) {
    const unsigned G = gridDim.x * gridDim.y * gridDim.z;
    unsigned sum, cnt, mine, sp = 0u;
    for (;;) {
        sum = 0u; cnt = 0u; mine = 0u;
#pragma unroll
        for (unsigned j = 0; j < 16; ++j) { const unsigned c = xb_ld(&bar[XB_XCNT(j)]); sum += c; cnt += (c > 0u) ? 1u : 0u; mine = (j == x) ? c : mine; }
        if (sum == G) break;
        __builtin_amdgcn_s_sleep(1);
        if ((++sp & 255u) == 0u) { if (xb_ld(&bar[XB_TMO])) break; if (sp > XB_SPIN_CAP) { atomicAdd(&bar[XB_TMO], 1u); break; } }
    }
    nloc = mine > 0u ? mine : 1u; nx = cnt > 0u ? cnt : 1u;
}

__device__ __forceinline__ void xcd_barrier(const XcdBarrier& b) {
    asm volatile("s_waitcnt vmcnt(0)" ::: "memory");
    __syncthreads();
    if (threadIdx.x == 0) {
        unsigned* bar = b.bar;
        __builtin_amdgcn_s_waitcnt(0);
        unsigned nloc = b.st[0], nx = b.st[1];
        if (nloc == 0u) { xcd_barrier_complete(bar, b.x, nloc, nx); b.st[0] = nloc; b.st[1] = nx; }
        const unsigned old = xb_add(&bar[XB_XSUB(b.x)], 1u);
        const unsigned gen = old / nloc;
        if (old + 1u == (gen + 1u) * nloc) {
            __builtin_amdgcn_fence(__ATOMIC_RELEASE, "agent");
            asm volatile("s_waitcnt vmcnt(0)" ::: "memory");
            const unsigned og = xb_add(&bar[XB_TOP], 1u);
            const unsigned tg = og / nx;
            if (og + 1u == (tg + 1u) * nx) xb_add(&bar[XB_TOPGEN], 1u);
            else XB_SPIN(xb_ld(&bar[XB_TOPGEN]) == tg, bar);
            __builtin_amdgcn_fence(__ATOMIC_ACQUIRE, "agent");
            xb_add(&bar[XB_XGEN(b.x)], 1u);
            asm volatile("s_waitcnt vmcnt(0)" ::: "memory");
        } else {
            XB_SPIN(xb_ld(&bar[XB_XGEN(b.x)]) == gen, bar);
            __builtin_amdgcn_fence(__ATOMIC_ACQUIRE, "agent");
            asm volatile("s_waitcnt vmcnt(0)" ::: "memory");
        }
    }
    __syncthreads();
}

typedef short bf16x8 __attribute__((ext_vector_type(8)));
typedef float f32x16 __attribute__((ext_vector_type(16)));
#define MFMA32(a, b, c) __builtin_amdgcn_mfma_f32_32x32x16_bf16((a), (b), (c), 0, 0, 0)
using pg8::cvtpk;
constexpr float LOG2E = 1.4426950408889634f;
__device__ __forceinline__ constexpr int kofs(int i) { return (i & 3) + 4 * ((i >> 2) & 1) + 16 * (i >> 3); }
template <int DH, class LF>
__device__ __forceinline__ void attn_run(const bf16* kb, const bf16* vb, int t0, int t1, const bf16x8 (&qf)[DH / 16], f32x16 (&o)[DH / 32], float& m_run, float& l_run, LF&& lf) {
    constexpr int KS = DH / 16, ND = DH / 32, TS = 32 * DH;
    bf16x8 kf[KS];
#pragma unroll
    for (int s = 0; s < KS; ++s) kf[s] = *(const bf16x8*)(kb + s * 512);
#pragma unroll 1
    for (int t = t0; t <= t1; ++t) {
        bf16x8 vf[2][ND];
#pragma unroll
        for (int s2 = 0; s2 < 2; ++s2)
#pragma unroll
            for (int dg = 0; dg < ND; ++dg) vf[s2][dg] = *(const bf16x8*)(vb + s2 * (2 * DH * 8) + dg * 256);
        f32x16 st;
#pragma unroll
        for (int i = 0; i < 16; ++i) st[i] = 0.f;
#pragma unroll
        for (int s = 0; s < KS; ++s) st = MFMA32(kf[s], qf[s], st);
        if (t < t1) kb += TS;
        vb += TS;
#pragma unroll
        for (int s = 0; s < KS; ++s) kf[s] = *(const bf16x8*)(kb + s * 512);
        lf(t, st);
        float tmax = fmaxf(fmaxf(st[0], st[1]), st[2]);
#pragma unroll
        for (int i = 3; i < 15; i += 2) tmax = fmaxf(fmaxf(tmax, st[i]), st[i + 1]);
        tmax = fmaxf(tmax, st[15]);
        { auto rr_ = __builtin_amdgcn_permlane32_swap(__float_as_uint(tmax), __float_as_uint(tmax), false, false); tmax = fmaxf(__uint_as_float(rr_[0]), __uint_as_float(rr_[1])); }
        if (__any(tmax > m_run + 8.0f)) {
            const float mn = fmaxf(m_run, tmax), corr = __builtin_amdgcn_exp2f(m_run - mn); m_run = mn; l_run *= corr;
#pragma unroll
            for (int dg = 0; dg < ND; ++dg) o[dg] = o[dg] * corr;
        }
        st = st - m_run;
#pragma unroll
        for (int i = 0; i < 16; ++i) st[i] = __builtin_amdgcn_exp2f(st[i]);
        { float ps = ((st[0] + st[1]) + (st[2] + st[3])) + ((st[4] + st[5]) + (st[6] + st[7])) + ((st[8] + st[9]) + (st[10] + st[11])) + ((st[12] + st[13]) + (st[14] + st[15]));
          { auto rr_ = __builtin_amdgcn_permlane32_swap(__float_as_uint(ps), __float_as_uint(ps), false, false); ps = __uint_as_float(rr_[0]) + __uint_as_float(rr_[1]); } l_run += ps; }
        v4u p0, p1; p0.x = cvtpk(st[0], st[1]); p0.y = cvtpk(st[2], st[3]); p0.z = cvtpk(st[4], st[5]); p0.w = cvtpk(st[6], st[7]);
        p1.x = cvtpk(st[8], st[9]); p1.y = cvtpk(st[10], st[11]); p1.z = cvtpk(st[12], st[13]); p1.w = cvtpk(st[14], st[15]);
        const bf16x8 pf0 = __builtin_bit_cast(bf16x8, p0), pf1 = __builtin_bit_cast(bf16x8, p1);
#pragma unroll
        for (int dg = 0; dg < ND; ++dg) { o[dg] = MFMA32(vf[0][dg], pf0, o[dg]); o[dg] = MFMA32(vf[1][dg], pf1, o[dg]); }
    }
}

template <int DH, class LF, class VF>
__device__ __forceinline__ void attn_tile_tail(int t, f32x16& st, f32x16 (&o)[DH / 32], float& m_run, float& l_run, LF&& lf, VF&& vfrag) {
    constexpr int ND = DH / 32;
    lf(t, st);
    for (int vr_ = 1; vr_ < NREP(13); ++vr_) { f32x16 d_ = st; asm volatile("" : "+v"(d_)); float dm_ = fmaxf(fmaxf(d_[0], d_[1]), d_[2]);
#pragma unroll
        for (int i = 3; i < 15; i += 2) dm_ = fmaxf(fmaxf(dm_, d_[i]), d_[i + 1]);
        dm_ = fmaxf(dm_, __shfl_xor(dm_, 32)); d_ = d_ - dm_;
#pragma unroll
        for (int i = 0; i < 16; ++i) d_[i] = __builtin_amdgcn_exp2f(d_[i]);
        float ds_ = 0.f;
#pragma unroll
        for (int i = 0; i < 16; ++i) ds_ += d_[i];
        ds_ += __shfl_xor(ds_, 32); unsigned dp_ = 0;
#pragma unroll
        for (int i = 0; i < 16; i += 2) dp_ ^= cvtpk(d_[i], d_[i + 1]);
        asm volatile("" :: "v"(ds_), "v"(dp_)); }
    float tmax = fmaxf(fmaxf(st[0], st[1]), st[2]);
#pragma unroll
    for (int i = 3; i < 15; i += 2) tmax = fmaxf(fmaxf(tmax, st[i]), st[i + 1]);
    tmax = fmaxf(tmax, st[15]);
    { auto rr_ = __builtin_amdgcn_permlane32_swap(__float_as_uint(tmax), __float_as_uint(tmax), false, false); tmax = fmaxf(__uint_as_float(rr_[0]), __uint_as_float(rr_[1])); }
    if (__any(tmax > m_run + 8.0f)) {
        const float mn = fmaxf(m_run, tmax), corr = __builtin_amdgcn_exp2f(m_run - mn); m_run = mn; l_run *= corr;
#pragma unroll
        for (int dg = 0; dg < ND; ++dg) o[dg] = o[dg] * corr;
    }
    st = st - m_run;
#pragma unroll
    for (int i = 0; i < 16; ++i) st[i] = __builtin_amdgcn_exp2f(st[i]);
    { float ps = ((st[0] + st[1]) + (st[2] + st[3])) + ((st[4] + st[5]) + (st[6] + st[7])) + ((st[8] + st[9]) + (st[10] + st[11])) + ((st[12] + st[13]) + (st[14] + st[15]));
      { auto rr_ = __builtin_amdgcn_permlane32_swap(__float_as_uint(ps), __float_as_uint(ps), false, false); ps = __uint_as_float(rr_[0]) + __uint_as_float(rr_[1]); } l_run += ps; }
    v4u p0, p1; p0.x = cvtpk(st[0], st[1]); p0.y = cvtpk(st[2], st[3]); p0.z = cvtpk(st[4], st[5]); p0.w = cvtpk(st[6], st[7]);
    p1.x = cvtpk(st[8], st[9]); p1.y = cvtpk(st[10], st[11]); p1.z = cvtpk(st[12], st[13]); p1.w = cvtpk(st[14], st[15]);
    const bf16x8 pf0 = __builtin_bit_cast(bf16x8, p0), pf1 = __builtin_bit_cast(bf16x8, p1);
#pragma unroll
    for (int dg = 0; dg < ND; ++dg) { o[dg] = MFMA32(vfrag(0, dg), pf0, o[dg]); o[dg] = MFMA32(vfrag(1, dg), pf1, o[dg]); }
    for (int pr_ = 1; pr_ < NREP(14); ++pr_) { bf16x8 z_ = {0, 0, 0, 0, 0, 0, 0, 0}; asm volatile("" : "+v"(z_));
#pragma unroll
        for (int dg = 0; dg < ND; ++dg) { o[dg] = MFMA32(vfrag(0, dg), z_, o[dg]); o[dg] = MFMA32(vfrag(1, dg), z_, o[dg]); } }
}
template <int DH>
__device__ __forceinline__ void attn_store(bf16* orow, const f32x16 (&o)[DH / 32], float l_run, int h) {
    const float il = 1.0f / l_run;
#pragma unroll
    for (int dg = 0; dg < DH / 32; ++dg)
#pragma unroll
        for (int g = 0; g < 4; g += 2) {
            unsigned ax = cvtpk(o[dg][4 * g] * il, o[dg][4 * g + 1] * il), ay = cvtpk(o[dg][4 * g + 2] * il, o[dg][4 * g + 3] * il);
            unsigned bx = cvtpk(o[dg][4 * g + 4] * il, o[dg][4 * g + 5] * il), by = cvtpk(o[dg][4 * g + 6] * il, o[dg][4 * g + 7] * il);
            { auto rr = __builtin_amdgcn_permlane32_swap(ax, bx, false, false); ax = rr[0]; bx = rr[1]; }
            { auto rr = __builtin_amdgcn_permlane32_swap(ay, by, false, false); ay = rr[0]; by = rr[1]; }
            v4u w; w.x = ax; w.y = ay; w.z = bx; w.w = by;
            *(v4u*)(orow + dg * 32 + 8 * g + 8 * h) = w; }
}
#define TOP3_INSERT(g, n) do { if ((g) > s0) { s2 = s1; i2 = i1; s1 = s0; i1 = i0; s0 = (g); i0 = (n); } else if ((g) > s1) { s2 = s1; i2 = i1; s1 = (g); i1 = (n); } else if ((g) > s2) { s2 = (g); i2 = (n); } } while (0)

__device__ __forceinline__ void build_bias_table(LAS unsigned char* lds, const float* rel_bias, bool window) {
    for (int i = threadIdx.x; i < 8 * TABW; i += NWAVES * 64) { const int h = i / TABW, k = i % TABW, d = k - TPAD;
        float v = -INFINITY;
        if (d >= 0 && d < 128) v = rel_bias[rel_bucket(d) * 8 + h] * LOG2E; else if (d >= 128 && !window) v = rel_bias[31 * 8 + h] * LOG2E;
        ((LAS float*)(lds + LDS_TAB_OFF))[i] = v; }
}
template <int l> __device__ __forceinline__ void layer_body(const Args& args, LAS unsigned char* lds, const XcdBarrier& bar) {
    int tid_ = threadIdx.x; asm volatile("" : "+v"(tid_));
    const int tid = tid_, lane = tid & 63, wave = __builtin_amdgcn_readfirstlane(tid >> 6);
    const int G = gridDim.x, bx = blockIdx.x;
    unsigned char* ws = args.ws;
    float* KSUM = (float*)(ws + WS_KSUM); float* SS = (float*)(ws + WS_SS);
    bf16* W = (bf16*)(ws + WS_W); bf16* XKP = (bf16*)(ws + WS_XKP); bf16* XVP = (bf16*)(ws + WS_XVP); bf16* KPAN = (bf16*)(ws + WS_KPAN); bf16* VPAN = (bf16*)(ws + WS_VPAN);
    const LAS float* tabl = (const LAS float*)(lds + LDS_TAB_OFF); const int r = lane & 31, hh = lane >> 5, pr = (r & ~12) | ((r & 4) << 1) | ((r & 8) >> 1);
    bf16* XB = (bf16*)(ws + WS_XB); bf16* Y = (bf16*)(ws + WS_Y); bf16* R1 = (bf16*)(ws + WS_R1); bf16* XQ = (bf16*)(ws + WS_XQ); bf16* XO = (bf16*)(ws + WS_XO);
    const float* x_in = args.in[0]; float* OUT = args.out;
        float* ssl = SS + (size_t)(4 * l) * T * 2; constexpr size_t TS16 = (size_t)T * 2;
        for (int rep = 0; rep < NREP(0); ++rep) { pg8::Gemm g{XB, W + WO_GU1 + l * W_GU, T, 2 * FF, D}; pg8::StaticOrder S; S.init(T, 2 * FF, G, bx);
          pg8::EpiSwiglu E{R1, FF, ssl};
          pg8::gemm_phase<pg8::EpiSwiglu, pg8::StaticOrder, true, true>(lds, g, S, E); }
        GSYNC();
        for (int rep = 0; rep < NREP(1); ++rep) { const bool fin = rep == NREP(1) - 1; pg8::Gemm g{R1, W + WO_DN1 + l * W_DN, T, D, FF}; pg8::StaticOrder S; S.init(T, D, G, bx);
          pg8::EpiResid E{l == 0 ? x_in : nullptr, XB, fin ? ssl + TS16 : SS + 9 * TS16, fin ? 0.5f : 0.0f};
          pg8::gemm_phase<pg8::EpiResid, pg8::StaticOrder, true, true>(lds, g, S, E); }
        GSYNC();
        const int NIN = (l == 0) ? EV_IN : OD_IN;
        for (int rep = 0; rep < NREP(2); ++rep) { pg8::Gemm g{XB, W + (l == 0 ? WO_EVIN : WO_ODIN), T, NIN, D}; pg8::StaticOrder S; S.init(T, NIN, G, bx);
          pg8::EpiQKV E{R1, NIN, ssl + TS16, KPAN, VPAN, l == 0 ? 2048 : 1024, l == 0 ? 2176 : 1536, l == 0 ? 6 : 7, l == 0 ? 2 : 4, 12, l == 0 ? nullptr : KSUM};
          pg8::gemm_phase<pg8::EpiQKV, pg8::StaticOrder, true, true>(lds, g, S, E); }
        if (l == 0) {
#pragma unroll
            for (int lk = 0; lk < 2; ++lk) { pg8::Gemm g{(const bf16*)(ws + WS_MEMN), W + WO_XKV + (size_t)lk * 1024 * D, MEMROWS, 1024, D}; pg8::StaticOrder S; S.init(MEMROWS, 1024, G, (bx + G - (128 + 32 * lk) % G) % G);
              pg8::EpiQKV E{nullptr, 0, nullptr, XKP + (size_t)lk * 32 * 8 * 4096, XVP + (size_t)lk * 32 * 8 * 4096, 0, 512, 7, 4, 8, nullptr};
              pg8::gemm_phase<pg8::EpiQKV, pg8::StaticOrder, true, true>(lds, g, S, E); }
        }
        GSYNC();
        if (l == 0) {
            const bf16* Z = R1; const float* cw = args.in[8];
            for (int rep = 0; rep < NREP(3); ++rep) for (int w_ = bx; w_ < T / 128; w_ += G) { const int w = (w_ & 7) * 32 + (w_ >> 3);
                { const int c = (tid & 63) * 8;
                  const f32x4 wa0 = *(const f32x4*)(cw + c), wa1 = *(const f32x4*)(cw + c + 4), wb0 = *(const f32x4*)(cw + 512 + c), wb1 = *(const f32x4*)(cw + 512 + c + 4), wc0 = *(const f32x4*)(cw + 1024 + c), wc1 = *(const f32x4*)(cw + 1024 + c + 4);
#define CONV2(k, W0a, W0b, W1a, W1b, W2a, W2b) cvtpk(bflo(bg[q_][k]) * ((W2a) * bflo(c0[q_][k]) * bflo(u0[q_][k]) + (W1a) * bflo(c1[q_][k]) * bflo(u1[q_][k]) + (W0a) * bflo(c2[q_][k]) * bflo(u2[q_][k])), \
                                                      bfhi(bg[q_][k]) * ((W2b) * bfhi(c0[q_][k]) * bfhi(u0[q_][k]) + (W1b) * bfhi(c1[q_][k]) * bfhi(u1[q_][k]) + (W0b) * bfhi(c2[q_][k]) * bfhi(u2[q_][k])))
                  for (int i = 0; i < 16; i += 2) { v4u bg[2], c0[2], u0[2], c1[2], u1[2], c2[2], u2[2];
#pragma unroll
                    for (int q_ = 0; q_ < 2; ++q_) { const int t = w * 128 + (tid >> 6) + 8 * (i + q_), pos = t & (SEQ - 1); const bf16* zr = Z + (size_t)t * EV_IN + c;
                        bg[q_] = *(const v4u*)zr; c0[q_] = *(const v4u*)(zr + 512); u0[q_] = *(const v4u*)(zr + 1024);
                        c1[q_] = (v4u){0, 0, 0, 0}; u1[q_] = (v4u){0, 0, 0, 0}; c2[q_] = (v4u){0, 0, 0, 0}; u2[q_] = (v4u){0, 0, 0, 0};
                        if (pos >= 1) { c1[q_] = *(const v4u*)(zr + 512 - EV_IN); u1[q_] = *(const v4u*)(zr + 1024 - EV_IN); }
                        if (pos >= 2) { c2[q_] = *(const v4u*)(zr + 512 - 2 * EV_IN); u2[q_] = *(const v4u*)(zr + 1024 - 2 * EV_IN); } }
#pragma unroll
                    for (int q_ = 0; q_ < 2; ++q_) { const int t = w * 128 + (tid >> 6) + 8 * (i + q_); v4u o;
                        o.x = CONV2(0, wa0[0], wa0[1], wb0[0], wb0[1], wc0[0], wc0[1]); o.y = CONV2(1, wa0[2], wa0[3], wb0[2], wb0[3], wc0[2], wc0[3]);
                        o.z = CONV2(2, wa1[0], wa1[1], wb1[0], wb1[1], wc1[0], wc1[1]); o.w = CONV2(3, wa1[2], wa1[3], wb1[2], wb1[3], wc1[2], wc1[3]);
                        *(v4u*)(Y + (size_t)t * D + c) = o; } }
#undef CONV2
                }
                const int hd = wave, kvh = hd >> 2; const float sink2 = args.in[9][hd] * LOG2E; const LAS float* tb = tabl + hd * TABW;
                for (int jj = 0; jj < 4; ++jj) { const int qt = w * 4 + jj, b = qt >> 7, j = qt & 127, q0g = qt * 32;
                    bf16x8 qf[4];
#pragma unroll
                    for (int s = 0; s < 4; ++s) qf[s] = *(const bf16x8*)(Z + (size_t)(q0g + r) * EV_IN + 1536 + hd * 64 + 16 * s + 8 * hh);
                    f32x16 o[2];
#pragma unroll
                    for (int i = 0; i < 16; ++i) { o[0][i] = 0.f; o[1][i] = 0.f; }
                    float m_run = sink2, l_run = 1.0f;
                    const int t0 = j >= 4 ? j - 4 : 0; const size_t tb0 = ((size_t)(b * 2 + kvh) * 128 + t0) * 2048;
                    const int qpos = j * 32 + r;
                    attn_run<64>(KPAN + tb0 + (hh * 32 + pr) * 8, VPAN + tb0 + (hh * 64 + r) * 8, t0, j, qf, o, m_run, l_run, [&](int t, f32x16& st) {
                        const LAS float* bp = tb + (TPAD - 23) + (qpos - t * 32 - 8 * hh);
#pragma unroll
                        for (int i = 0; i < 16; ++i) st[i] = __builtin_fmaf(st[i], 0.125f * LOG2E, bp[23 - kofs(i)]); });
                    attn_store<64>(Y + (size_t)(q0g + r) * D + 512 + hd * 64, o, l_run, hh); }
            }
        } else {
            const bf16* Z = R1;
            build_bias_table(lds, args.in[13], false); __syncthreads();
            const LAS float* tb0_ = tabl; const float scale2 = 0.08838834764831845f * LOG2E;
            for (int rep = 0; rep < NREP(4); ++rep) for (int w = bx; w < 256; w += G) { const int b = w & 7, kvh = (w >> 3) & 3, uu = w >> 5;
                for (int jj = 0; jj < 4; ++jj) { const int jg = (jj == 0) ? uu : (jj == 1) ? 15 - uu : (jj == 2) ? 16 + uu : 31 - uu;
                    const int j = jg * 4 + (wave >> 1), jmax = jg * 4 + 3, hd = kvh * 2 + (wave & 1), own = j >> 3, q0g = b * SEQ + j * 32;
                    const LAS float* tb = tb0_ + hd * TABW; const float b128 = tb[TPAD + 128];
                    const bf16* kgu = KPAN + (size_t)(b * 4 + kvh) * 128 * 4096; const bf16* vgu = VPAN + (size_t)(b * 4 + kvh) * 128 * 4096; const unsigned so = (unsigned)tid * 8u;
#define DMA16(gsrc, ldsoff) __builtin_amdgcn_global_load_lds((const unsigned*)(gsrc), (LAS unsigned*)(lds + (ldsoff) + wave * 1024), 16, 0, 0)
#define DMA_PAIR(u_, pb_) do { DMA16(kgu + (size_t)(2 * (u_)) * 4096 + so, (pb_)); DMA16(kgu + (size_t)(2 * (u_) + 1) * 4096 + so, (pb_) + 8192); DMA16(vgu + (size_t)(2 * (u_)) * 4096 + so, 32768 + (pb_)); DMA16(vgu + (size_t)(2 * (u_) + 1) * 4096 + so, 32768 + (pb_) + 8192); } while (0)
                    DMA_PAIR(0, 0);
                    bf16x8 qf[8];
#pragma unroll
                    for (int s = 0; s < 8; ++s) qf[s] = *(const bf16x8*)(Z + (size_t)(q0g + r) * OD_IN + hd * 128 + 16 * s + 8 * hh);
                    unsigned selmask = 0u;
                    if (own > 0) {
                        f32x16 gt;
#pragma unroll
                        for (int i = 0; i < 16; ++i) gt[i] = 0.f;
                        const long long* ks = (const long long*)KSUM + ((size_t)(b * 4 + kvh) * 16 + (r & 15)) * 128 + 8 * hh;
#pragma unroll
                        for (int s = 0; s < 8; ++s) { f32x4 a0, a1;
#pragma unroll
                            for (int e = 0; e < 4; ++e) { a0[e] = (float)ks[16 * s + e] * (1.0f / 4294967296.0f); a1[e] = (float)ks[16 * s + 4 + e] * (1.0f / 4294967296.0f); }
                            v4u hi; hi.x = cvtpk(a0[0], a0[1]); hi.y = cvtpk(a0[2], a0[3]); hi.z = cvtpk(a1[0], a1[1]); hi.w = cvtpk(a1[2], a1[3]);
                            v4u lo; lo.x = cvtpk(a0[0] - bflo(hi.x), a0[1] - bfhi(hi.x)); lo.y = cvtpk(a0[2] - bflo(hi.y), a0[3] - bfhi(hi.y)); lo.z = cvtpk(a1[0] - bflo(hi.z), a1[1] - bfhi(hi.z)); lo.w = cvtpk(a1[2] - bflo(hi.w), a1[3] - bfhi(hi.w));
                            gt = MFMA32(__builtin_bit_cast(bf16x8, hi), qf[s], gt); gt = MFMA32(__builtin_bit_cast(bf16x8, lo), qf[s], gt); }
                        float glo[8], ghi[8];
#pragma unroll
                        for (int i = 0; i < 8; ++i) { const float mine = gt[i], oth = __shfl_xor(mine, 32); glo[i] = hh ? oth : mine; ghi[i] = hh ? mine : oth; }
                        float s0 = -INFINITY, s1 = -INFINITY, s2 = -INFINITY; int i0 = -1, i1 = -1, i2 = -1;
#pragma unroll
                        for (int n = 0; n < 16; ++n) { const float g = (n & 4) ? ghi[(n & 3) + 4 * (n >> 3)] : glo[(n & 3) + 4 * (n >> 3)]; if (n < own) TOP3_INSERT(g, n); }
                        selmask = (i0 >= 0 ? 1u << i0 : 0u) | (i1 >= 0 ? 1u << i1 : 0u) | (i2 >= 0 ? 1u << i2 : 0u);
                    }
                    f32x16 o[4];
#pragma unroll
                    for (int dg = 0; dg < 4; ++dg)
#pragma unroll
                        for (int i = 0; i < 16; ++i) o[dg][i] = 0.f;
                    float m_run = -1e30f, l_run = 0.f; const int qpos = j * 32 + r;
                    __syncthreads();
                    const int umax = 2 * jg + 1;
                    auto logits = [&](int tt, f32x16& s_) {
                        const int n = tt >> 3; const bool sel = (n >= own) || ((selmask >> n) & 1u);
                        if (j * 32 - (tt * 32 + 31) >= 128) { const float madd = sel ? b128 : -INFINITY; s_ = s_ * scale2 + madd; }
                        else { const LAS float* bp = tb + (TPAD - 23) + (qpos - tt * 32 - 8 * hh); const float madd = sel ? 0.0f : -INFINITY;
#pragma unroll
                            for (int i = 0; i < 16; ++i) s_[i] = __builtin_fmaf(s_[i], scale2, bp[23 - kofs(i)] + madd); } };
#pragma unroll 1
                    for (int u = 0; u <= umax; ++u) {
                        if (u < umax) DMA_PAIR(u + 1, ((u + 1) & 1) * 16384);
                        if (2 * u <= j) {
                            const int ta = 2 * u; const bool hasb = (ta + 1 <= j);
                            const LAS bf16* kl = (const LAS bf16*)(lds + (u & 1) * 16384) + (hh * 32 + pr) * 8; const LAS bf16* vl = (const LAS bf16*)(lds + 32768 + (u & 1) * 16384) + (hh * 128 + r) * 8;
                            f32x16 st0, st1;
                            { bf16x8 kfa[8], kfb[8];
#pragma unroll
                              for (int s = 0; s < 8; ++s) { kfa[s] = *(const LAS bf16x8*)(kl + s * 512); kfb[s] = *(const LAS bf16x8*)(kl + 4096 + s * 512); }
#pragma unroll
                              for (int i = 0; i < 16; ++i) { st0[i] = 0.f; st1[i] = 0.f; }
#pragma unroll
                              for (int s = 0; s < 8; ++s) { st0 = MFMA32(kfa[s], qf[s], st0); st1 = MFMA32(kfb[s], qf[s], st1); } }
                            if (hasb) logits(ta + 1, st1);
                            else {
#pragma unroll
                              for (int i = 0; i < 16; ++i) st1[i] = -INFINITY; }
                            logits(ta, st0);
                            float tmax = fmaxf(fmaxf(st0[0], st0[1]), st0[2]);
#pragma unroll
                            for (int i = 3; i < 15; i += 2) tmax = fmaxf(fmaxf(tmax, st0[i]), st0[i + 1]);
                            tmax = fmaxf(tmax, st0[15]);
#pragma unroll
                            for (int i = 0; i < 16; i += 2) tmax = fmaxf(fmaxf(tmax, st1[i]), st1[i + 1]);
                            { auto rr_ = __builtin_amdgcn_permlane32_swap(__float_as_uint(tmax), __float_as_uint(tmax), false, false); tmax = fmaxf(__uint_as_float(rr_[0]), __uint_as_float(rr_[1])); }
                            if (__any(tmax > m_run + 8.0f)) {
                                const float mn = fmaxf(m_run, tmax), corr = __builtin_amdgcn_exp2f(m_run - mn); m_run = mn; l_run *= corr;
#pragma unroll
                                for (int dg = 0; dg < 4; ++dg) o[dg] = o[dg] * corr;
                            }
                            st0 = st0 - m_run; st1 = st1 - m_run;
#pragma unroll
                            for (int i = 0; i < 16; ++i) { st0[i] = __builtin_amdgcn_exp2f(st0[i]); st1[i] = __builtin_amdgcn_exp2f(st1[i]); }
                            { float ps = (((st0[0] + st0[1]) + (st0[2] + st0[3])) + ((st0[4] + st0[5]) + (st0[6] + st0[7]))) + (((st0[8] + st0[9]) + (st0[10] + st0[11])) + ((st0[12] + st0[13]) + (st0[14] + st0[15])));
                              ps += (((st1[0] + st1[1]) + (st1[2] + st1[3])) + ((st1[4] + st1[5]) + (st1[6] + st1[7]))) + (((st1[8] + st1[9]) + (st1[10] + st1[11])) + ((st1[12] + st1[13]) + (st1[14] + st1[15])));
                              { auto rr_ = __builtin_amdgcn_permlane32_swap(__float_as_uint(ps), __float_as_uint(ps), false, false); ps = __uint_as_float(rr_[0]) + __uint_as_float(rr_[1]); }
                              l_run += ps; }
                            { v4u p0, p1; p0.x = cvtpk(st0[0], st0[1]); p0.y = cvtpk(st0[2], st0[3]); p0.z = cvtpk(st0[4], st0[5]); p0.w = cvtpk(st0[6], st0[7]);
                              p1.x = cvtpk(st0[8], st0[9]); p1.y = cvtpk(st0[10], st0[11]); p1.z = cvtpk(st0[12], st0[13]); p1.w = cvtpk(st0[14], st0[15]);
                              const bf16x8 pf0 = __builtin_bit_cast(bf16x8, p0), pf1 = __builtin_bit_cast(bf16x8, p1);
#pragma unroll
                              for (int dg = 0; dg < 4; ++dg) { o[dg] = MFMA32(*(const LAS bf16x8*)(vl + dg * 256), pf0, o[dg]); o[dg] = MFMA32(*(const LAS bf16x8*)(vl + 2048 + dg * 256), pf1, o[dg]); } }
                            { v4u p0, p1; p0.x = cvtpk(st1[0], st1[1]); p0.y = cvtpk(st1[2], st1[3]); p0.z = cvtpk(st1[4], st1[5]); p0.w = cvtpk(st1[6], st1[7]);
                              p1.x = cvtpk(st1[8], st1[9]); p1.y = cvtpk(st1[10], st1[11]); p1.z = cvtpk(st1[12], st1[13]); p1.w = cvtpk(st1[14], st1[15]);
                              const bf16x8 pf0 = __builtin_bit_cast(bf16x8, p0), pf1 = __builtin_bit_cast(bf16x8, p1);
#pragma unroll
                              for (int dg = 0; dg < 4; ++dg) { o[dg] = MFMA32(*(const LAS bf16x8*)(vl + 4096 + dg * 256), pf0, o[dg]); o[dg] = MFMA32(*(const LAS bf16x8*)(vl + 4096 + 2048 + dg * 256), pf1, o[dg]); } }
                        }
                        __syncthreads();
                    }
#undef DMA_PAIR
#undef DMA16
                    attn_store<128>(Y + (size_t)(q0g + r) * D + hd * 128, o, l_run, hh); }
            }
        }
        GSYNC();
        for (int rep = 0; rep < NREP(5); ++rep) { const bool fin = rep == NREP(5) - 1; pg8::Gemm g{Y, W + (l == 0 ? WO_EVOUT : WO_ODOUT), T, D, D}; pg8::StaticOrder S; S.init(T, D, G, bx);
          pg8::EpiResid E{nullptr, XB, fin ? ssl + 2 * TS16 : SS + 9 * TS16, fin ? 1.0f : 0.0f};
          pg8::gemm_phase<pg8::EpiResid, pg8::StaticOrder, true, true>(lds, g, S, E); }
        GSYNC();
        for (int rep = 0; rep < NREP(6); ++rep) { pg8::Gemm g{XB, W + WO_XQ + (size_t)l * XAW * D, T, XAW, D}; pg8::StaticOrder S; S.init(T, XAW, G, bx);
          pg8::EpiScaleBf16 E{XQ, XAW, ssl + 2 * TS16};
          pg8::gemm_phase<pg8::EpiScaleBf16, pg8::StaticOrder, true, true>(lds, g, S, E); }
        GSYNC();
        { const int hd = wave & 3; const float scale2 = 0.08838834764831845f * LOG2E;
          for (int rep = 0; rep < NREP(7); ++rep) for (int w = bx; w < T / 128; w += G)
            for (int jj = 0; jj < 2; ++jj) { const int qt = w * 4 + (wave >> 2) * 2 + jj, b = qt >> 7, q0g = qt * 32;
                bf16x8 qf[8];
#pragma unroll
                for (int s = 0; s < 8; ++s) qf[s] = *(const bf16x8*)(XQ + (size_t)(q0g + r) * XAW + hd * 128 + 16 * s + 8 * hh);
                f32x16 o[4];
#pragma unroll
                for (int dg = 0; dg < 4; ++dg)
#pragma unroll
                    for (int i = 0; i < 16; ++i) o[dg][i] = 0.f;
                float m_run = -1e30f, l_run = 0.f;
                const size_t tb0 = ((size_t)l * 32 + b * 4 + hd) * 8 * 4096;
                attn_run<128>(XKP + tb0 + (hh * 32 + pr) * 8, XVP + tb0 + (hh * 128 + r) * 8, 0, 7, qf, o, m_run, l_run, [&](int t, f32x16& st) {
#pragma unroll
                    for (int i = 0; i < 16; ++i) st[i] *= scale2; });
                attn_store<128>(XO + (size_t)(q0g + r) * XAW + hd * 128, o, l_run, hh); } }
        GSYNC();
        for (int rep = 0; rep < NREP(8); ++rep) { const bool fin = rep == NREP(8) - 1; pg8::Gemm g{XO, W + WO_XO + (size_t)l * D * XAW, T, D, XAW}; pg8::StaticOrder S; S.init(T, D, G, bx);
          pg8::EpiResid E{nullptr, XB, fin ? ssl + 3 * TS16 : SS + 9 * TS16, fin ? 1.0f : 0.0f};
          pg8::gemm_phase<pg8::EpiResid, pg8::StaticOrder, true, true>(lds, g, S, E); }
        GSYNC();
        for (int rep = 0; rep < NREP(0); ++rep) { pg8::Gemm g{XB, W + WO_GU2 + l * W_GU, T, 2 * FF, D}; pg8::StaticOrder S; S.init(T, 2 * FF, G, bx);
          pg8::EpiSwiglu E{R1, FF, ssl + 3 * TS16};
          pg8::gemm_phase<pg8::EpiSwiglu, pg8::StaticOrder, true, true>(lds, g, S, E); }
        GSYNC();
        for (int rep = 0; rep < NREP(1); ++rep) { const bool fin = rep == NREP(1) - 1; pg8::Gemm g{R1, W + WO_DN2 + l * W_DN, T, D, FF}; pg8::StaticOrder S; S.init(T, D, G, bx);
          pg8::EpiResid E{nullptr, XB, fin ? ssl + 4 * TS16 : SS + 9 * TS16, fin ? 0.5f : 0.0f};
          pg8::gemm_phase<pg8::EpiResid, pg8::StaticOrder, true, true>(lds, g, S, E); }
        GSYNC();
}

__global__ void __launch_bounds__(NWAVES * 64, 2) mk_fwd(Args args) {
    extern __shared__ __attribute__((aligned(16))) unsigned char lds_raw[];
    cg::grid_group grid = cg::this_grid();
    LAS unsigned char* lds = (LAS unsigned char*)lds_raw;
    const int tid = threadIdx.x, lane = tid & 63, wave = __builtin_amdgcn_readfirstlane(tid >> 6);
    const int G = gridDim.x, bx = blockIdx.x;
    const int gw = bx * NWAVES + wave, NGW = G * NWAVES;
    unsigned char* ws = args.ws;
    float* KSUM = (float*)(ws + WS_KSUM); float* SS = (float*)(ws + WS_SS);
    bf16* W = (bf16*)(ws + WS_W); bf16* MEMN = (bf16*)(ws + WS_MEMN); bf16* XKP = (bf16*)(ws + WS_XKP); bf16* XVP = (bf16*)(ws + WS_XVP);
    bf16* XB = (bf16*)(ws + WS_XB);
    const float* x_in = args.in[0]; float* OUT = args.out;
    if (tid < 2) ((LAS unsigned*)(lds + LDS_BARST_OFF))[tid] = 0u;
    __syncthreads();
    const XcdBarrier bar = xcd_barrier_post((unsigned*)(ws + WS_BAR), (volatile LAS unsigned*)(lds + LDS_BARST_OFF));

    for (int prep = 0; prep < NREP(10); ++prep) {
        LAS float* scr = (LAS float*)(lds + wave * 16384);
        for (int it = gw; it < N_JOB_ITEMS; it += NGW) {
            int r = it, j = 0; Job jb;
            for (;;) { jb = get_job(j, args, W); const int cnt = (jb.K / 64) * (jb.N / 32); if (r < cnt || j >= 21) break; r -= cnt; ++j; }
            transpose_item(jb, scr, r, lane);
        }
        for (int m0 = gw; m0 < T; m0 += 4 * NGW) {
            f32x4 v[4][4];
#pragma unroll
            for (int k = 0; k < 4; ++k) { const int m = m0 + k * NGW; if (m < T) { const f32x4* xr = (const f32x4*)(x_in + (size_t)m * D) + lane;
#pragma unroll
                for (int j = 0; j < 4; ++j) v[k][j] = xr[64 * j]; } }
#pragma unroll
            for (int k = 0; k < 4; ++k) { const int m = m0 + k * NGW; if (m < T) { float s = 0.f;
#pragma unroll
                for (int j = 0; j < 4; ++j) s += (v[k][j].x * v[k][j].x + v[k][j].y * v[k][j].y) + (v[k][j].z * v[k][j].z + v[k][j].w * v[k][j].w);
                s = wave_sum(s);
                v2u* o8 = (v2u*)(XB + (size_t)m * D) + lane;
#pragma unroll
                for (int j = 0; j < 4; ++j) { v2u o; o.x = pk2(v[k][j].x, v[k][j].y); o.y = pk2(v[k][j].z, v[k][j].w); o8[64 * j] = o; }
                if (lane == 0) ((unsigned long long*)SS)[m] = (unsigned long long)(s * 4294967296.0f); } }
        }
        for (int m = gw; m < MEMROWS; m += NGW) {
            const f32x4* xr = (const f32x4*)(args.in[1] + (size_t)m * D) + lane; const f32x4* gr = (const f32x4*)(args.in[18]) + lane; float s = 0.f; f32x4 v[4];
#pragma unroll
            for (int j = 0; j < 4; ++j) { v[j] = xr[64 * j]; s += (v[j].x * v[j].x + v[j].y * v[j].y) + (v[j].z * v[j].z + v[j].w * v[j].w); }
            s = wave_sum(s); const float rs = 1.0f / sqrtf(s * (1.0f / D) + 1e-6f);
            v2u* o8 = (v2u*)(MEMN + (size_t)m * D) + lane;
#pragma unroll
            for (int j = 0; j < 4; ++j) { const f32x4 g = gr[64 * j]; v2u o; o.x = pk2(v[j].x * rs * g.x, v[j].y * rs * g.y); o.y = pk2(v[j].z * rs * g.z, v[j].w * rs * g.w); o8[64 * j] = o; }
        }
        for (int i = bx * 512 + tid; i < 9 * T; i += G * 512) ((unsigned long long*)SS)[T + i] = 0ull;
        for (int i = bx * 512 + tid; i < NBATCH * 4 * 16 * 128; i += G * 512) ((unsigned long long*)KSUM)[i] = 0ull;
        build_bias_table(lds, args.in[13], true);
    }
    if (args.ws == nullptr) grid.sync();
    xcd_barrier(bar);

    layer_body<0>(args, lds, bar);
    layer_body<1>(args, lds, bar);
    int tidf_ = threadIdx.x; asm volatile("" : "+v"(tidf_)); const int lanef = tidf_ & 63, gwf = bx * NWAVES + __builtin_amdgcn_readfirstlane(tidf_ >> 6);
    for (int m0 = gwf; m0 < T; m0 += 4 * NGW) {
        const f32x4* gr = (const f32x4*)(args.in[23]) + lanef; v2u w[4][4];
#pragma unroll
        for (int k = 0; k < 4; ++k) { const int m = m0 + k * NGW; if (m < T) { const v2u* xr = (const v2u*)(XB + (size_t)m * D) + lanef;
#pragma unroll
            for (int j = 0; j < 4; ++j) w[k][j] = xr[64 * j]; } }
#pragma unroll
        for (int k = 0; k < 4; ++k) { const int m = m0 + k * NGW; if (m < T) { f32x4* orow = (f32x4*)(OUT + (size_t)m * D) + lanef; float s = 0.f; f32x4 v[4];
#pragma unroll
            for (int j = 0; j < 4; ++j) { v[j] = (f32x4){bflo(w[k][j].x), bfhi(w[k][j].x), bflo(w[k][j].y), bfhi(w[k][j].y)}; s += (v[j].x * v[j].x + v[j].y * v[j].y) + (v[j].z * v[j].z + v[j].w * v[j].w); }
            s = wave_sum(s); const float rs = 1.0f / sqrtf(s * (1.0f / D) + 1e-6f);
#pragma unroll
            for (int j = 0; j < 4; ++j) { const f32x4 g = gr[64 * j]; orow[64 * j] = (f32x4){v[j].x * rs * g.x, v[j].y * rs * g.y, v[j].z * rs * g.z, v[j].w * rs * g.w}; } } }
    }
}

extern "C" void kernel_launch(void* const* d_in, const int* in_sizes, int n_in, void* d_out, int out_size, void* d_ws, size_t ws_size, hipStream_t stream) {
    static int grid = 0;
    if (grid == 0) {
        if (n_in != 24 || in_sizes[0] != T * D || out_size != T * D || ws_size < WS_END) { fprintf(stderr, "kernel_launch: unexpected shapes (n_in %d, in0 %d, out %d, ws %zu)\n", n_in, n_in > 0 ? in_sizes[0] : -1, out_size, ws_size); grid = -1; return; }
        int dev = 0, cus = 0, per_cu = 0;
        (void)hipGetDevice(&dev); (void)hipDeviceGetAttribute(&cus, hipDeviceAttributeMultiprocessorCount, dev);
        if (hipFuncSetAttribute((const void*)mk_fwd, hipFuncAttributeMaxDynamicSharedMemorySize, LDS_BYTES) != hipSuccess) { fprintf(stderr, "kernel_launch: hipFuncSetAttribute failed\n"); grid = -1; return; }
        if (hipOccupancyMaxActiveBlocksPerMultiprocessor(&per_cu, (const void*)mk_fwd, NWAVES * 64, LDS_BYTES) != hipSuccess || per_cu < 1) { fprintf(stderr, "kernel_launch: occupancy query says %d\n", per_cu); per_cu = 1; }
        (void)hipGetLastError();
        grid = cus;
        if (grid <= 0) grid = 256;
    }
    if (grid < 0) return;
    if (hipMemsetAsync((char*)d_ws + WS_BAR, 0, XCD_BAR_WORDS * 4, stream) != hipSuccess) { fprintf(stderr, "kernel_launch: memset failed\n"); return; }
    Args a{};
    for (int i = 0; i < 24; ++i) a.in[i] = (const float*)d_in[i];
    a.out = (float*)d_out; a.ws = (unsigned char*)d_ws;
    void* kargs[] = {&a};
    hipError_t e = hipLaunchCooperativeKernel((const void*)mk_fwd, dim3(grid), dim3(NWAVES * 64), kargs, LDS_BYTES, stream);
    if (e != hipSuccess) fprintf(stderr, "kernel_launch: cooperative launch failed: %s (grid %d)\n", hipGetErrorString(e), grid);
}
```
